# Optimizing an MI355X kernel written in HIP

```python
import jax, jax.numpy as jnp
from jax import lax
import numpy as np

D_MODEL = 1024
BATCH = 4
SEQ = 8192
DEPTH = 2

CHUNK = 64
Q_BLOCK = 128
FOX_HEADS = 8
FOX_HEAD_DIM = 64
FOX_WIDTH = FOX_HEADS * FOX_HEAD_DIM
CONV_WIDTH = 512
CONV_K = 3
EVEN_IN = 3 * FOX_WIDTH + FOX_HEADS + 3 * CONV_WIDTH
EVEN_MIX = FOX_WIDTH + CONV_WIDTH
GMLP_BLOCK = 128
GMLP_GROUPS = 8
GMLP_WIDTH = D_MODEL
GMLP_GROUP_DIM = GMLP_WIDTH // GMLP_GROUPS
FFN_HIDDEN = -(-8 * D_MODEL // (3 * 256)) * 256
ALPHA = (2.0 * DEPTH) ** 0.25
BETA = (8.0 * DEPTH) ** -0.25
N_EVEN = (DEPTH + 1) // 2
N_ODD = DEPTH // 2
LN_EPS = 1e-5

kernel_name = "fox_shortconv_gmlp_deepnorm_trunk"


def layer_norm(x, g, b):
    xf = x.astype(jnp.float32)
    mu = jnp.mean(xf, axis=-1, keepdims=True)
    var = jnp.mean(jnp.square(xf - mu), axis=-1, keepdims=True)
    return ((xf - mu) * lax.rsqrt(var + LN_EPS) * g + b).astype(x.dtype)


def forgetting_attention(q, k, v, log_f):
    bsz, s_len, h, dh = q.shape
    nb = s_len // Q_BLOCK
    c = jnp.cumsum(log_f, axis=1).transpose(0, 2, 1)
    kh = k.transpose(0, 2, 1, 3)
    vh = v.transpose(0, 2, 1, 3)
    qb = q.reshape(bsz, nb, Q_BLOCK, h, dh).transpose(1, 0, 3, 2, 4)
    cb = c.reshape(bsz, h, nb, Q_BLOCK).transpose(2, 0, 1, 3)
    pos = jnp.arange(s_len)
    posb = pos.reshape(nb, Q_BLOCK)
    scale = dh ** -0.5

    def block(args):
        q_blk, c_blk, p_blk = args
        s = jnp.einsum('bhqd,bhkd->bhqk', q_blk, kh,
                       preferred_element_type=jnp.float32) * scale
        s = s + c_blk[..., :, None] - c[..., None, :]
        s = jnp.where(p_blk[:, None] >= pos[None, :], s, -jnp.inf)
        p = jax.nn.softmax(s, axis=-1)
        return jnp.einsum('bhqk,bhkd->bhqd', p.astype(vh.dtype), vh)

    o = lax.map(block, (qb, cb, posb))
    return o.transpose(1, 0, 3, 2, 4).reshape(bsz, s_len, h * dh)


def short_conv_mixer(h, b_gate, c_gate, conv_w):
    s_len = h.shape[1]
    z = c_gate * h
    zp = jnp.pad(z, ((0, 0), (CONV_K - 1, 0), (0, 0)))
    y = conv_w[0] * zp[:, 0:s_len]
    for i in range(1, CONV_K):
        y = y + conv_w[i] * zp[:, i:i + s_len]
    return b_gate * y


def fox_conv_mixer(x, w_in, b_f, conv_w, w_out):
    bsz, s_len, _ = x.shape
    proj = x @ w_in
    cuts = np.cumsum([FOX_WIDTH, FOX_WIDTH, FOX_WIDTH, FOX_HEADS, CONV_WIDTH, CONV_WIDTH]).tolist()
    q, k, v, f_logit, b_gate, c_gate, h = jnp.split(proj, cuts, axis=-1)
    log_f = jax.nn.log_sigmoid((f_logit + b_f).astype(jnp.float32))
    heads = (bsz, s_len, FOX_HEADS, FOX_HEAD_DIM)
    attn = forgetting_attention(q.reshape(heads), k.reshape(heads), v.reshape(heads), log_f)
    conv = short_conv_mixer(h, b_gate, c_gate, conv_w)
    return jnp.concatenate([attn.astype(x.dtype), conv], axis=-1) @ w_out


def gmlp_mixer(x, w_in, v_ln_g, v_ln_b, w_s, b_s, w_out):
    bsz, s_len, _ = x.shape
    uv = jax.nn.gelu(x @ w_in, approximate=False)
    u, v = jnp.split(uv, 2, axis=-1)
    v = layer_norm(v, v_ln_g, v_ln_b)
    nc = s_len // GMLP_BLOCK
    vb = v.reshape(bsz, nc, GMLP_BLOCK, GMLP_GROUPS, GMLP_GROUP_DIM)
    chunk_id = jnp.arange(GMLP_BLOCK) // CHUNK
    mask = chunk_id[None, :] <= chunk_id[:, None]
    w = jnp.where(mask[None], w_s, jnp.zeros((), w_s.dtype))
    s = jnp.einsum('gij,bcjgd->bcigd', w, vb) + b_s.T[None, None, :, :, None]
    return (u * s.reshape(bsz, s_len, GMLP_WIDTH)) @ w_out


def swiglu(x, w_in, w_out):
    gate, up = jnp.split(x @ w_in, 2, axis=-1)
    return (jax.nn.silu(gate) * up) @ w_out


def setup_inputs(seed: int = 0) -> dict:
    key = jax.random.key(seed)
    ks = jax.random.split(key, 20)
    nrm = jax.random.normal
    f32 = jnp.float32
    return {
        "x": nrm(ks[0], (BATCH, SEQ, D_MODEL), f32),
        "even_w_in": nrm(ks[1], (N_EVEN, D_MODEL, EVEN_IN), f32) * D_MODEL ** -0.5,
        "even_b_f": jax.random.uniform(ks[2], (N_EVEN, FOX_HEADS), f32, 1.0, 5.0),
        "even_conv_w": nrm(ks[3], (N_EVEN, CONV_K, CONV_WIDTH), f32) * CONV_K ** -0.5,
        "even_w_out": nrm(ks[4], (N_EVEN, EVEN_MIX, D_MODEL), f32) * (EVEN_MIX ** -0.5 * BETA),
        "odd_w_in": nrm(ks[5], (N_ODD, D_MODEL, 2 * GMLP_WIDTH), f32) * D_MODEL ** -0.5,
        "odd_v_ln_g": 1.0 + 0.1 * nrm(ks[6], (N_ODD, GMLP_WIDTH), f32),
        "odd_v_ln_b": 0.1 * nrm(ks[7], (N_ODD, GMLP_WIDTH), f32),
        "odd_w_s": nrm(ks[8], (N_ODD, GMLP_GROUPS, GMLP_BLOCK, GMLP_BLOCK), f32) * GMLP_BLOCK ** -0.5,
        "odd_b_s": 1.0 + 0.1 * nrm(ks[9], (N_ODD, GMLP_GROUPS, GMLP_BLOCK), f32),
        "odd_w_out": nrm(ks[10], (N_ODD, GMLP_WIDTH, D_MODEL), f32) * (GMLP_WIDTH ** -0.5 * BETA),
        "mix_ln_g": 1.0 + 0.1 * nrm(ks[11], (DEPTH, D_MODEL), f32),
        "mix_ln_b": 0.1 * nrm(ks[12], (DEPTH, D_MODEL), f32),
        "ffn_w_in": nrm(ks[13], (DEPTH, D_MODEL, 2 * FFN_HIDDEN), f32) * D_MODEL ** -0.5,
        "ffn_w_out": nrm(ks[14], (DEPTH, FFN_HIDDEN, D_MODEL), f32) * (FFN_HIDDEN ** -0.5 * BETA),
        "ffn_ln_g": 1.0 + 0.1 * nrm(ks[15], (DEPTH, D_MODEL), f32),
        "ffn_ln_b": 0.1 * nrm(ks[16], (DEPTH, D_MODEL), f32),
    }


def reference(x, even_w_in, even_b_f, even_conv_w, even_w_out, odd_w_in, odd_v_ln_g,
              odd_v_ln_b, odd_w_s, odd_b_s, odd_w_out, mix_ln_g, mix_ln_b, ffn_w_in,
              ffn_w_out, ffn_ln_g, ffn_ln_b):
    for layer in range(DEPTH):
        i = layer // 2
        if layer % 2 == 0:
            m = fox_conv_mixer(x, even_w_in[i], even_b_f[i], even_conv_w[i], even_w_out[i])
        else:
            m = gmlp_mixer(x, odd_w_in[i], odd_v_ln_g[i], odd_v_ln_b[i], odd_w_s[i],
                           odd_b_s[i], odd_w_out[i])
        x = layer_norm(ALPHA * x + m, mix_ln_g[layer], mix_ln_b[layer])
        x = layer_norm(ALPHA * x + swiglu(x, ffn_w_in[layer], ffn_w_out[layer]),
                       ffn_ln_g[layer], ffn_ln_b[layer])
    return x
```

```cpp
#include <hip/hip_runtime.h>
#include <cstdio>
#include <cstdint>
__device__ __forceinline__ int mk_lane_id() { int l; asm volatile("v_mbcnt_lo_u32_b32 %0, -1, 0\n\tv_mbcnt_hi_u32_b32 %0, -1, %0" : "=v"(l)); return l; }
namespace pg8 {
#define PG8_LAS __attribute__((address_space(3)))
typedef unsigned short bf16_t;
typedef short bf16x8 __attribute__((ext_vector_type(8)));
typedef float f32x4 __attribute__((ext_vector_type(4)));
typedef unsigned u32x4 __attribute__((ext_vector_type(4)));
constexpr int BM = 256, BK = 64, HALF = 128, HTB = HALF * BK * 2  , STAGE_BYTES = 8 * HTB, NXCD = 8, WGM = 8;

__host__ __device__ __forceinline__ int lds_byte(int r, int c) { const int st = (r >> 4) * 2 + (c >> 5), rr = r & 15, cc = c & 31, ob = rr * 64 + cc * 2; return st * 1024 + (ob ^ (((ob >> 9) & 1) << 5)); }
__host__ __device__ __forceinline__ void stage_rc(int b, int& R, int& C) { const int st = b / 1024, sb = b % 1024, swz = sb ^ (((sb >> 9) & 1) << 5); R = (st >> 1) * 16 + swz / 64; C = (st & 1) * 32 + (swz % 64) / 2; }
__host__ __device__ __forceinline__ int perm32(int rho) { const int n = rho >> 4, i = rho & 15; return 8 * (i >> 2) + 4 * n + (i & 3); }

struct Unit { int pm, pn; };
struct Gemm { const bf16_t* A; const bf16_t* Bt; int M, N, K; };

struct StaticOrder {
    int nM, nN, nwg, G, c;
    __host__ __device__ void init(int M, int N, int G_, int c_) { nM = M / BM; nN = N / BM; nwg = nM * nN; G = G_; c = c_; }
    __host__ __device__ bool next(int i, Unit& u) const {
        const long L = (long)i * G + c; if (L >= nwg) return false;
        int wgid = (int)L; { const int q = nwg / NXCD, r = nwg % NXCD, xcd = wgid % NXCD, off = wgid / NXCD; wgid = (xcd < r ? xcd * (q + 1) : r * (q + 1) + (xcd - r) * q) + off; }
        const int nig = WGM * nN, gid = wgid / nig, fm = gid * WGM, gsz = (nM - fm) < WGM ? (nM - fm) : WGM;
        u.pm = fm + ((wgid % nig) % gsz); u.pn = (wgid % nig) / gsz; return true;
    }
    __device__ __forceinline__ void a_ready(const Unit&) const {}
    __device__ __forceinline__ void done(const Unit&) const {}
};

__device__ __forceinline__ unsigned cvt_pk_bf16(float lo, float hi) { unsigned r; asm volatile("v_cvt_pk_bf16_f32 %0, %1, %2" : "=v"(r) : "v"(lo), "v"(hi)); return r; }
typedef float f32x2 __attribute__((ext_vector_type(2)));
__device__ __forceinline__ f32x2 gelu_pk(f32x2 v) {
    const f32x2 av = __builtin_elementwise_abs(v), d = av * 0.2316418882f + 1.0f;
    f32x2 t; t.x = __builtin_amdgcn_rcpf(d.x); t.y = __builtin_amdgcn_rcpf(d.y);
    f32x2 q = t * 0.5307027145f + (-0.7265760135f); q = q * t + 0.7107068705f; q = q * t + (-0.142248368f); q = q * t + 0.127414796f; q = q * t;
    const f32x2 s = (v * v) * (-0.72134752044f);
    f32x2 e; e.x = __builtin_amdgcn_exp2f(s.x); e.y = __builtin_amdgcn_exp2f(s.y);
    const f32x2 m = v * (q * e), r = v - m;
    f32x2 o; o.x = v.x < 0.f ? m.x : r.x; o.y = v.y < 0.f ? m.y : r.y; return o;
}

template <int ACT  > struct EpiBf16 {
    static constexpr bool PERM = true, AFTER_DRAIN = false; static_assert(ACT == 0 || ACT == 1, "EpiBf16: ACT is 0 (none) or 1 (gelu_pk)");
    bf16_t* O; int ldc; const float* bias; int split_cols; size_t split_stride; float scale0;
    __device__ __forceinline__ void operator()(const f32x4 (&acc)[2][2][4][2], const Unit& u, int wr, int wc, int fr, int fq) const {
        const int row0 = u.pm * BM + wr * 64 + fr; int colt = u.pn * BM; bf16_t* base = O;
        float sc = 1.f; if (split_cols) { const int t = colt / split_cols; base += (size_t)t * split_stride; colt -= t * split_cols; if (t == 0) sc = scale0; }
        const int col0 = colt + wc * 32 + 8 * fq, bcol0 = u.pn * BM + wc * 32 + 8 * fq;
        f32x4 bv[2][2];
#pragma unroll
        for (int bj = 0; bj < 2; ++bj)
#pragma unroll
            for (int n = 0; n < 2; ++n) bv[bj][n] = bias ? *(const f32x4*)(bias + bcol0 + bj * HALF + 4 * n) : (f32x4){0.f, 0.f, 0.f, 0.f};
#pragma unroll
        for (int ai = 0; ai < 2; ++ai)
#pragma unroll
            for (int m = 0; m < 4; ++m) { bf16_t* rowp = base + (size_t)(row0 + ai * HALF + m * 16) * ldc + col0;
#pragma unroll
                for (int bj = 0; bj < 2; ++bj) { f32x4 v0 = acc[ai][bj][m][0] + bv[bj][0], v1 = acc[ai][bj][m][1] + bv[bj][1];
                    if (ACT == 1) { f32x2 a = gelu_pk((f32x2){v0[0], v0[1]}), b = gelu_pk((f32x2){v0[2], v0[3]}), c = gelu_pk((f32x2){v1[0], v1[1]}), d = gelu_pk((f32x2){v1[2], v1[3]});
                        v0 = (f32x4){a.x, a.y, b.x, b.y}; v1 = (f32x4){c.x, c.y, d.x, d.y}; }
                    v0 = v0 * sc; v1 = v1 * sc; u32x4 w; w.x = cvt_pk_bf16(v0[0], v0[1]); w.y = cvt_pk_bf16(v0[2], v0[3]); w.z = cvt_pk_bf16(v1[0], v1[1]); w.w = cvt_pk_bf16(v1[2], v1[3]);
                    *(u32x4*)(rowp + bj * HALF) = w; } }
    }
};

struct PanelStats {
    unsigned* xbuf;
    unsigned* cnt;
    unsigned* tmo;
    int ntn; float eps;
    unsigned code;
    __device__ __forceinline__ bool run(const f32x4 (&v)[2][2][4][2], const Unit& u, int wr, int wc, int fr, int fq, PG8_LAS unsigned char* lds, int wid, int lane) const {
        typedef float f32x2v __attribute__((ext_vector_type(2)));
        PG8_LAS f32x2v* P = (PG8_LAS f32x2v*)lds;
        PG8_LAS f32x2v* S = (PG8_LAS f32x2v*)(lds + 8192);
        PG8_LAS unsigned* flag = (PG8_LAS unsigned*)(lds + 8192 + 2048);
#pragma unroll
        for (int ai = 0; ai < 2; ++ai)
#pragma unroll
            for (int m = 0; m < 4; ++m) {
                float s = 0.f;
#pragma unroll
                for (int bj = 0; bj < 2; ++bj)
#pragma unroll
                    for (int n = 0; n < 2; ++n) { const f32x4 x = v[ai][bj][m][n]; s += (x[0] + x[1]) + (x[2] + x[3]); }
                s += __shfl_xor(s, 16); s += __shfl_xor(s, 32);
                const float mw = s * (1.0f / 64.0f); float q = 0.f;
#pragma unroll
                for (int bj = 0; bj < 2; ++bj)
#pragma unroll
                    for (int n = 0; n < 2; ++n) { const f32x4 d = v[ai][bj][m][n] - mw; q += (d[0] * d[0] + d[1] * d[1]) + (d[2] * d[2] + d[3] * d[3]); }
                q += __shfl_xor(q, 16); q += __shfl_xor(q, 32);
                if (fq == 0) P[(ai * HALF + wr * 64 + m * 16 + fr) * 4 + wc] = (f32x2v){mw, q};
            }
        asm volatile("s_waitcnt lgkmcnt(0)" ::: "memory"); __builtin_amdgcn_s_barrier(); asm volatile("" ::: "memory");
        const int row = wid * 32 + (lane & 31);
        unsigned long long* slots = (unsigned long long*)xbuf + (size_t)(u.pm * BM + row) * 4;
        if (wid == 0 && lane == 0) flag[0] = 0u;
        if (lane < 32) {
            const f32x2v a = P[row * 4 + 0], b = P[row * 4 + 1], c = P[row * 4 + 2], d = P[row * 4 + 3];
            const float mt = (a.x + b.x + c.x + d.x) * 0.25f;
            const float da = a.x - mt, db = b.x - mt, dc = c.x - mt, dd = d.x - mt;
            const float m2 = (a.y + b.y) + (c.y + d.y) + 64.0f * ((da * da + db * db) + (dc * dc + dd * dd));
            __hip_atomic_store(slots + u.pn, ((unsigned long long)(__float_as_uint(m2) | 1u) << 32) | __float_as_uint(mt), __ATOMIC_RELAXED, __HIP_MEMORY_SCOPE_AGENT);
        }
        if (lane < 32) {
            unsigned long long w[4]; unsigned spins = 0u; bool dead = false;
            for (;;) {
                bool all = true;
#pragma unroll
                for (int t = 0; t < 4; ++t) { w[t] = (t < ntn) ? __hip_atomic_load(slots + t, __ATOMIC_RELAXED, __HIP_MEMORY_SCOPE_AGENT) : 1ull; all = all && (w[t] != 0ull); }
#if defined(BROKEN_EXCHANGE_NO_WAIT)
                break;
#endif
                if (all) break;
                if (++spins > (1u << 16)) { dead = true; break; }
                __builtin_amdgcn_s_sleep(2);
            }
            if (dead) { unsigned expect = 0u; __hip_atomic_compare_exchange_strong(tmo + 1, &expect, code | (unsigned)(u.pm & 0xff), __ATOMIC_RELAXED, __ATOMIC_RELAXED, __HIP_MEMORY_SCOPE_AGENT);
                        __hip_atomic_store(tmo, 1u, __ATOMIC_RELAXED, __HIP_MEMORY_SCOPE_AGENT); flag[0] = 1u; }
            float mt[4], m2[4]; float ms = 0.f;
#pragma unroll
            for (int t = 0; t < 4; ++t) { if (t < ntn) { mt[t] = __uint_as_float((unsigned)w[t]); m2[t] = __uint_as_float((unsigned)(w[t] >> 32)); } else { mt[t] = 0.f; m2[t] = 0.f; } ms += mt[t]; }
            const float mean = ms / (float)ntn; float q = 0.f;
#pragma unroll
            for (int t = 0; t < 4; ++t) if (t < ntn) { const float dm = mt[t] - mean; q += m2[t] + 256.0f * dm * dm; }
            S[row] = (f32x2v){mean, 1.0f / sqrtf(q / (256.0f * (float)ntn) + eps)};
        }
        asm volatile("s_waitcnt vmcnt(0) lgkmcnt(0)" ::: "memory"); __builtin_amdgcn_s_barrier(); asm volatile("" ::: "memory");
        const bool bad = flag[0] != 0u;
        return bad;
    }
};
struct EpiLnRes {
    static constexpr bool PERM = false, AFTER_DRAIN = true;
    const float* base; float* out; int ldc; const float* bias; PanelStats st; unsigned poison;
    __device__ __forceinline__ void fused(f32x4 (&acc)[2][2][4][2], const Unit& u, int wr, int wc, int fr, int fq, PG8_LAS unsigned char* lds, int wid, int lane) const {
        typedef float f32x2v __attribute__((ext_vector_type(2)));
        const PG8_LAS f32x2v* S = (const PG8_LAS f32x2v*)(lds + 8192);
        const int col0 = u.pn * BM + wc * 32 + 4 * fq;
#pragma unroll
        for (int bj = 0; bj < 2; ++bj)
#pragma unroll
            for (int n = 0; n < 2; ++n) { const f32x4 bv = bias ? *(const f32x4*)(bias + col0 + bj * HALF + n * 16) : (f32x4){0.f, 0.f, 0.f, 0.f};
#pragma unroll
                for (int ai = 0; ai < 2; ++ai)
#pragma unroll
                    for (int m = 0; m < 4; ++m) acc[ai][bj][m][n] += bv; }
        f32x4 pre[4][2][2];
#pragma unroll
        for (int m = 0; m < 4; ++m) { const size_t off = (size_t)(u.pm * BM + wr * 64 + m * 16 + fr) * ldc + col0;
#pragma unroll
            for (int bj = 0; bj < 2; ++bj)
#pragma unroll
                for (int n = 0; n < 2; ++n) pre[m][bj][n] = *(const f32x4*)(base + off + bj * HALF + n * 16); }
        const bool bad = st.run(acc, u, wr, wc, fr, fq, lds, wid, lane) || poison != 0u;
        const float qnan = __builtin_nanf("");
#pragma unroll
        for (int ai = 0; ai < 2; ++ai)
#pragma unroll
            for (int m = 0; m < 4; ++m) { const int r = ai * HALF + wr * 64 + m * 16 + fr; const f32x2v sr = S[r]; const size_t off = (size_t)(u.pm * BM + r) * ldc + col0;
#pragma unroll
                for (int bj = 0; bj < 2; ++bj)
#pragma unroll
                    for (int n = 0; n < 2; ++n) { const f32x4 bs = ai == 0 ? pre[m][bj][n] : *(const f32x4*)(base + off + bj * HALF + n * 16); f32x4 o = bs + (acc[ai][bj][m][n] - sr.x) * sr.y;
                        if (bad) o = (f32x4){qnan, qnan, qnan, qnan}; *(f32x4*)(out + off + bj * HALF + n * 16) = o; }
                if (m & 1) asm volatile("" ::: "memory"); }
    }
};
struct EpiLnResLn {
    static constexpr bool PERM = false, AFTER_DRAIN = true;
    const float* base; float* out; bf16_t* xn; int ldc; const float* bias; PanelStats st1, st2; unsigned poison;
    __device__ __forceinline__ void fused(f32x4 (&acc)[2][2][4][2], const Unit& u, int wr, int wc, int fr, int fq, PG8_LAS unsigned char* lds, int wid, int lane) const {
        typedef float f32x2v __attribute__((ext_vector_type(2))); typedef unsigned u32x2v __attribute__((ext_vector_type(2)));
        const PG8_LAS f32x2v* S = (const PG8_LAS f32x2v*)(lds + 8192);
        const int col0 = u.pn * BM + wc * 32 + 4 * fq;
#pragma unroll
        for (int bj = 0; bj < 2; ++bj)
#pragma unroll
            for (int n = 0; n < 2; ++n) { const f32x4 bv = bias ? *(const f32x4*)(bias + col0 + bj * HALF + n * 16) : (f32x4){0.f, 0.f, 0.f, 0.f};
#pragma unroll
                for (int ai = 0; ai < 2; ++ai)
#pragma unroll
                    for (int m = 0; m < 4; ++m) acc[ai][bj][m][n] += bv; }
        bool bad = st1.run(acc, u, wr, wc, fr, fq, lds, wid, lane) || poison != 0u;
        const float qnan = __builtin_nanf("");
#pragma unroll
        for (int ai = 0; ai < 2; ++ai)
#pragma unroll
            for (int m = 0; m < 4; ++m) { const int r = ai * HALF + wr * 64 + m * 16 + fr; const f32x2v sr = S[r]; const size_t off = (size_t)(u.pm * BM + r) * ldc + col0;
#pragma unroll
                for (int bj = 0; bj < 2; ++bj)
#pragma unroll
                    for (int n = 0; n < 2; ++n) { const f32x4 bs = *(const f32x4*)(base + off + bj * HALF + n * 16); acc[ai][bj][m][n] = bs + (acc[ai][bj][m][n] - sr.x) * sr.y; }
                asm volatile("" : "+v"(acc[ai][0][m][0]), "+v"(acc[ai][0][m][1]), "+v"(acc[ai][1][m][0]), "+v"(acc[ai][1][m][1]));
                if (m & 1) asm volatile("" ::: "memory"); }
        const bool bad1 = bad;
        bad = st2.run(acc, u, wr, wc, fr, fq, lds, wid, lane) || bad;
#pragma unroll
        for (int ai = 0; ai < 2; ++ai)
#pragma unroll
            for (int m = 0; m < 4; ++m) { const int r = ai * HALF + wr * 64 + m * 16 + fr; const f32x2v sr = S[r]; const size_t off = (size_t)(u.pm * BM + r) * ldc + col0;
#pragma unroll
                for (int bj = 0; bj < 2; ++bj)
#pragma unroll
                    for (int n = 0; n < 2; ++n) { const f32x4 x1 = acc[ai][bj][m][n]; *(f32x4*)(out + off + bj * HALF + n * 16) = bad1 ? (f32x4){qnan, qnan, qnan, qnan} : x1;
                        const f32x4 o = (x1 - sr.x) * sr.y; u32x2v w; w.x = cvt_pk_bf16(o[0], o[1]); w.y = cvt_pk_bf16(o[2], o[3]);
                        if (bad) { w.x = 0x7fc07fc0u; w.y = 0x7fc07fc0u; } *(u32x2v*)(xn + off + bj * HALF + n * 16) = w; }
                asm volatile("" ::: "memory"); }
    }
};

template <class Epi, class Sched, bool ALIGN_EPI = false, bool SP2 = false>
__device__ __forceinline__ void gemm_phase(PG8_LAS unsigned char* lds, const Gemm g, const Sched& S, const Epi& E, int wave_) {
    const int wid = __builtin_amdgcn_readfirstlane(wave_), lane = mk_lane_id(), tid = wid * 64 + lane, wr = wid >> 2, wc = wid & 3, fr = lane & 15, fq = lane >> 4;
    const int K = g.K, nt = K / BK;
    unsigned voffA[2], voffB[2];
#pragma unroll
    for (int i = 0; i < 2; ++i) { int R, C; stage_rc(tid * 16 + i * 8192, R, C); const int Rb = Epi::PERM ? ((R & ~31) + perm32(R & 31)) : R;
        voffA[i] = (unsigned)(R * K + C) * 2u; voffB[i] = (unsigned)(Rb * K + C) * 2u; }
    const size_t kstep = (size_t)(BK * 2);
    const size_t hstep = (size_t)HALF * K * 2;
    const size_t tstep = 2 * hstep;
    const unsigned ldsw = (unsigned)wid * 1024u;
    const int aoff = lds_byte(wr * 64 + fr, fq * 8), boff = lds_byte(wc * 32 + fr, fq * 8);
#define PG8_SA(b, h) (((b) * 2 + (h)) * HTB)
#define PG8_SB(b, h) ((4 + (b) * 2 + (h)) * HTB)
#define PG8_STAGE(bufoff, gbase, voff) do { _Pragma("unroll") for (int _i = 0; _i < 2; ++_i) \
        __builtin_amdgcn_global_load_lds((const unsigned*)((const char*)(gbase) + (voff)[_i]), (PG8_LAS unsigned*)(lds + (bufoff) + ldsw + _i * 8192), 16, 0, 0); } while (0)
#define PG8_LDA(dst, b, h) do { _Pragma("unroll") for (int m = 0; m < 4; ++m) _Pragma("unroll") for (int k = 0; k < 2; ++k) dst[m][k] = *(const PG8_LAS bf16x8*)(lds + PG8_SA(b, h) + aoff + m * 2048 + k * 1024); } while (0)
#define PG8_LDB(dst, b, h) do { _Pragma("unroll") for (int n = 0; n < 2; ++n) _Pragma("unroll") for (int k = 0; k < 2; ++k) dst[n][k] = *(const PG8_LAS bf16x8*)(lds + PG8_SB(b, h) + boff + n * 2048 + k * 1024); } while (0)
#define PG8_MMA(ai, bj, At, Bt) do { __builtin_amdgcn_s_setprio(1); _Pragma("unroll") for (int m = 0; m < 4; ++m) _Pragma("unroll") for (int n = 0; n < 2; ++n) _Pragma("unroll") for (int k = 0; k < 2; ++k) \
        acc[ai][bj][m][n] = __builtin_amdgcn_mfma_f32_16x16x32_bf16(Bt[n][k], At[m][k], acc[ai][bj][m][n], 0, 0, 0); __builtin_amdgcn_s_setprio(0); } while (0)
#define PG8_WAIT_V(n) asm volatile("s_waitcnt vmcnt(" #n ")" ::: "memory")
#define PG8_WAIT_L(n) asm volatile("s_waitcnt lgkmcnt(" #n ")" ::: "memory")
#define PG8_BAR __builtin_amdgcn_s_barrier()
#define PG8_SCHED __builtin_amdgcn_sched_barrier(0)
    Unit cur, nxt; int ui = 0;
    if (!S.next(0, cur)) return;
    f32x4 acc[2][2][4][2];
#pragma unroll
    for (int a = 0; a < 2; ++a)
#pragma unroll
        for (int b = 0; b < 2; ++b)
#pragma unroll
            for (int m = 0; m < 4; ++m)
#pragma unroll
                for (int n = 0; n < 2; ++n) acc[a][b][m][n] = (f32x4){0.f, 0.f, 0.f, 0.f};
    bf16x8 At[4][2], B0[2][2], B1[2][2];
    const char* cA = (const char*)g.A + (size_t)cur.pm * tstep; const char* cB = (const char*)g.Bt + (size_t)cur.pn * tstep;
    S.a_ready(cur);
    if constexpr (SP2) {
        PG8_STAGE(PG8_SB(0, 0), cB, voffB); PG8_STAGE(PG8_SB(0, 1), cB + hstep, voffB); PG8_STAGE(PG8_SA(0, 0), cA, voffA); PG8_STAGE(PG8_SA(0, 1), cA + hstep, voffA);
        if (wr == 1) PG8_BAR;
        PG8_WAIT_V(2); PG8_BAR;
        PG8_STAGE(PG8_SB(1, 0), cB + kstep, voffB); PG8_STAGE(PG8_SA(1, 0), cA + kstep, voffA); PG8_STAGE(PG8_SB(1, 1), cB + hstep + kstep, voffB);
        PG8_WAIT_V(6); PG8_BAR;
    } else {
        PG8_STAGE(PG8_SB(0, 0), cB, voffB); PG8_STAGE(PG8_SA(0, 0), cA, voffA); PG8_STAGE(PG8_SB(0, 1), cB + hstep, voffB); PG8_STAGE(PG8_SA(0, 1), cA + hstep, voffA);
        if (wr == 1) PG8_BAR;
        PG8_WAIT_V(4); PG8_BAR;
        PG8_STAGE(PG8_SB(1, 0), cB + kstep, voffB); PG8_STAGE(PG8_SA(1, 0), cA + kstep, voffA); PG8_STAGE(PG8_SB(1, 1), cB + hstep + kstep, voffB);
        PG8_WAIT_V(6); PG8_BAR;
    }
    for (;;) {
        const bool has_next = S.next(ui + 1, nxt);
        const char* nA = has_next ? (const char*)g.A + (size_t)nxt.pm * tstep : cA; const char* nB = has_next ? (const char*)g.Bt + (size_t)nxt.pn * tstep : cB;
        for (int t = 0; t < nt; t += 2) {
            const bool last = (t == nt - 2);
            const char* a1 = cA + (size_t)(t + 1) * kstep;
            const char* a2 = last ? nA : cA + (size_t)(t + 2) * kstep; const char* b2 = last ? nB : cB + (size_t)(t + 2) * kstep;
            const char* a3 = a2 + kstep; const char* b3 = b2 + kstep;
            if (last && has_next) S.a_ready(nxt);
            if constexpr (SP2) {
            PG8_LDB(B0, 0, 0); PG8_LDB(B1, 0, 1); PG8_SCHED; PG8_LDA(At, 0, 0); PG8_STAGE(PG8_SA(1, 1), a1 + hstep, voffA);
            PG8_WAIT_V(8); PG8_WAIT_L(0); PG8_BAR; PG8_MMA(0, 0, At, B0); PG8_MMA(0, 1, At, B1); PG8_BAR; PG8_SCHED;
            PG8_LDA(At, 0, 1); PG8_STAGE(PG8_SB(0, 0), b2, voffB); PG8_STAGE(PG8_SB(0, 1), b2 + hstep, voffB); PG8_STAGE(PG8_SA(0, 0), a2, voffA);
            PG8_WAIT_V(8); PG8_WAIT_L(0); PG8_BAR; PG8_MMA(1, 0, At, B0); PG8_MMA(1, 1, At, B1); PG8_BAR; PG8_SCHED;
            PG8_LDB(B0, 1, 0); PG8_LDB(B1, 1, 1); PG8_SCHED; PG8_LDA(At, 1, 0); PG8_STAGE(PG8_SA(0, 1), a2 + hstep, voffA);
            PG8_WAIT_V(8); PG8_WAIT_L(0); PG8_BAR; PG8_MMA(0, 0, At, B0); PG8_MMA(0, 1, At, B1); PG8_BAR; PG8_SCHED;
            PG8_LDA(At, 1, 1); PG8_STAGE(PG8_SB(1, 0), b3, voffB); PG8_STAGE(PG8_SB(1, 1), b3 + hstep, voffB); PG8_STAGE(PG8_SA(1, 0), a3, voffA);
            PG8_WAIT_V(8); PG8_WAIT_L(0); PG8_BAR; PG8_MMA(1, 0, At, B0); PG8_MMA(1, 1, At, B1); PG8_BAR; PG8_SCHED;
            } else {
            PG8_LDB(B0, 0, 0); PG8_SCHED; PG8_LDA(At, 0, 0); PG8_STAGE(PG8_SA(1, 1), a1 + hstep, voffA);
            PG8_WAIT_L(8); PG8_BAR; PG8_WAIT_L(0); PG8_MMA(0, 0, At, B0); PG8_BAR; PG8_SCHED;
            PG8_LDB(B1, 0, 1); PG8_STAGE(PG8_SB(0, 0), b2, voffB);
            PG8_BAR; PG8_WAIT_L(0); PG8_MMA(0, 1, At, B1); PG8_BAR;
            PG8_LDA(At, 0, 1); PG8_STAGE(PG8_SA(0, 0), a2, voffA);
            PG8_BAR; PG8_WAIT_L(0); PG8_MMA(1, 0, At, B0); PG8_BAR; PG8_SCHED;
            PG8_STAGE(PG8_SB(0, 1), b2 + hstep, voffB);
            PG8_WAIT_V(6); PG8_BAR; PG8_MMA(1, 1, At, B1); PG8_BAR;
            PG8_LDB(B0, 1, 0); PG8_SCHED; PG8_LDA(At, 1, 0); PG8_STAGE(PG8_SA(0, 1), a2 + hstep, voffA);
            PG8_WAIT_L(8); PG8_BAR; PG8_WAIT_L(0); PG8_MMA(0, 0, At, B0); PG8_BAR; PG8_SCHED;
            PG8_LDB(B1, 1, 1); PG8_STAGE(PG8_SB(1, 0), b3, voffB);
            PG8_BAR; PG8_WAIT_L(0); PG8_MMA(0, 1, At, B1); PG8_BAR;
            PG8_LDA(At, 1, 1); PG8_STAGE(PG8_SA(1, 0), a3, voffA);
            PG8_BAR; PG8_WAIT_L(0); PG8_MMA(1, 0, At, B0); PG8_BAR; PG8_SCHED;
            PG8_STAGE(PG8_SB(1, 1), b3 + hstep, voffB);
            PG8_WAIT_V(6); PG8_BAR; PG8_MMA(1, 1, At, B1); PG8_BAR;
            }
        }
        if constexpr (ALIGN_EPI) { if (wr == 0) PG8_BAR; }
        if constexpr (!Epi::AFTER_DRAIN) { E(acc, cur, wr, wc, fr, fq); S.done(cur); }
        if (!has_next) break;
#pragma unroll
        for (int a = 0; a < 2; ++a)
#pragma unroll
            for (int b = 0; b < 2; ++b)
#pragma unroll
                for (int m = 0; m < 4; ++m)
#pragma unroll
                    for (int n = 0; n < 2; ++n) acc[a][b][m][n] = (f32x4){0.f, 0.f, 0.f, 0.f};
        cur = nxt; cA = nA; cB = nB; ++ui;
        if constexpr (ALIGN_EPI) { if (wr == 1) PG8_BAR; }
    }
    PG8_WAIT_V(0);
    if constexpr (!ALIGN_EPI) { if (wr == 0) PG8_BAR; }
    PG8_BAR;
    if constexpr (Epi::AFTER_DRAIN) { E.fused(acc, cur, wr, wc, fr, fq, lds, wid, lane); S.done(cur); }
#undef PG8_SA
#undef PG8_SB
#undef PG8_STAGE
#undef PG8_LDA
#undef PG8_LDB
#undef PG8_MMA
#undef PG8_WAIT_V
#undef PG8_WAIT_L
#undef PG8_BAR
#undef PG8_SCHED
}
}


namespace pg8 {
struct EpiBf16QK {
    static constexpr bool PERM = true, AFTER_DRAIN = false;
    bf16_t* O; int ldc; int split_cols; size_t split_stride; unsigned* nrm;
    __device__ __forceinline__ void operator()(const f32x4 (&acc)[2][2][4][2], const Unit& u, int wr, int wc, int fr, int fq) const {
        const int row0 = u.pm * BM + wr * 64 + fr; int colt = u.pn * BM; bf16_t* base = O;
        { const int t = colt / split_cols; base += (size_t)t * split_stride; colt -= t * split_cols; }
        const int col0 = colt + wc * 32 + 8 * fq;
        float pmax[2] = {0.f, 0.f};
#pragma unroll
        for (int ai = 0; ai < 2; ++ai)
#pragma unroll
            for (int m = 0; m < 4; ++m) { bf16_t* rowp = base + (size_t)(row0 + ai * HALF + m * 16) * ldc + col0;
#pragma unroll
                for (int bj = 0; bj < 2; ++bj) { const f32x4 v0 = acc[ai][bj][m][0], v1 = acc[ai][bj][m][1];
                    u32x4 w; w.x = cvt_pk_bf16(v0[0], v0[1]); w.y = cvt_pk_bf16(v0[2], v0[3]); w.z = cvt_pk_bf16(v1[0], v1[1]); w.w = cvt_pk_bf16(v1[2], v1[3]);
                    *(u32x4*)(rowp + bj * HALF) = w;
                    if (u.pn < 4) { float ss = (v0[0] * v0[0] + v0[1] * v0[1]) + (v0[2] * v0[2] + v0[3] * v0[3]) + (v1[0] * v1[0] + v1[1] * v1[1]) + (v1[2] * v1[2] + v1[3] * v1[3]);
                        ss += __shfl_xor(ss, 16); ss += __shfl_xor(ss, 32); pmax[bj] = fmaxf(pmax[bj], ss); } } }
        if (u.pn < 4) {
#pragma unroll
            for (int bj = 0; bj < 2; ++bj) { float v = pmax[bj];
#pragma unroll
                for (int o = 1; o < 16; o <<= 1) v = fmaxf(v, __shfl_xor(v, o));
                if (fr == 0 && fq == 0) atomicMax(nrm + (u.pn >> 1) * 32 + (u.pm >> 5) * 8 + 4 * (u.pn & 1) + 2 * bj + (wc >> 1), __float_as_uint(v * 1.02f)); }
        }
    }
};
}

namespace pg8 {
struct EpiBf16VT {
    static constexpr bool PERM = true, AFTER_DRAIN = false;
    bf16_t* O; int ldc; float* part;
    __device__ __forceinline__ void operator()(const f32x4 (&acc)[2][2][4][2], const Unit& u, int wr, int wc, int fr, int fq) const {
        const int row0 = u.pm * BM + wr * 64 + fr, col0 = u.pn * BM + wc * 32 + 8 * fq;
#pragma unroll
        for (int bj = 0; bj < 2; ++bj) {
            float ps[8], pq[8];
#pragma unroll
            for (int e = 0; e < 8; ++e) { ps[e] = 0.f; pq[e] = 0.f; }
#pragma unroll
            for (int ai = 0; ai < 2; ++ai)
#pragma unroll
                for (int m = 0; m < 4; ++m) { bf16_t* rowp = O + (size_t)(row0 + ai * HALF + m * 16) * ldc + col0;
                    f32x4 v0 = acc[ai][bj][m][0], v1 = acc[ai][bj][m][1];
                    { f32x2 a = gelu_pk((f32x2){v0[0], v0[1]}), b = gelu_pk((f32x2){v0[2], v0[3]}), c = gelu_pk((f32x2){v1[0], v1[1]}), d = gelu_pk((f32x2){v1[2], v1[3]});
                      v0 = (f32x4){a.x, a.y, b.x, b.y}; v1 = (f32x4){c.x, c.y, d.x, d.y}; }
#pragma unroll
                    for (int e = 0; e < 4; ++e) { ps[e] += v0[e]; pq[e] += v0[e] * v0[e]; ps[4 + e] += v1[e]; pq[4 + e] += v1[e] * v1[e]; }
                    u32x4 w; w.x = cvt_pk_bf16(v0[0], v0[1]); w.y = cvt_pk_bf16(v0[2], v0[3]); w.z = cvt_pk_bf16(v1[0], v1[1]); w.w = cvt_pk_bf16(v1[2], v1[3]);
                    *(u32x4*)(rowp + bj * HALF) = w; }
            { const bool b3 = (fr & 8) != 0, b2 = (fr & 4) != 0, b1 = (fr & 2) != 0, b0 = (fr & 1) != 0;
              float t8[8], t4[4], t2[2];
#pragma unroll
              for (int i = 0; i < 8; ++i) { const float keep = b3 ? pq[i] : ps[i], send = b3 ? ps[i] : pq[i]; t8[i] = keep + __shfl_xor(send, 8); }
#pragma unroll
              for (int i = 0; i < 4; ++i) { const float keep = b2 ? t8[4 + i] : t8[i], send = b2 ? t8[i] : t8[4 + i]; t4[i] = keep + __shfl_xor(send, 4); }
#pragma unroll
              for (int i = 0; i < 2; ++i) { const float keep = b1 ? t4[2 + i] : t4[i], send = b1 ? t4[i] : t4[2 + i]; t2[i] = keep + __shfl_xor(send, 2); }
              const float t1 = (b0 ? t2[1] : t2[0]) + __shfl_xor(b0 ? t2[0] : t2[1], 1);
              const int e = (fr & 7);
              part[((size_t)(col0 + bj * HALF + e) * 8 + 2 * u.pm + wr) * 2 + (b3 ? 1 : 0)] = t1; }
        }
    }
};
}

#ifndef PG8_SP2
#define PG8_SP2 true
#endif
#ifndef PG8_ALIGN
#define PG8_ALIGN true
#endif
namespace pg8 {
struct EpiSwiGLU {
    static constexpr bool PERM = true, AFTER_DRAIN = false;
    bf16_t* O; int ldc;
    __device__ __forceinline__ void operator()(const f32x4 (&acc)[2][2][4][2], const Unit& u, int wr, int wc, int fr, int fq) const {
        const int row0 = u.pm * BM + wr * 64 + fr, col0 = u.pn * HALF + wc * 32 + 8 * fq;
#pragma unroll
        for (int ai = 0; ai < 2; ++ai)
#pragma unroll
            for (int m = 0; m < 4; ++m) { bf16_t* rowp = O + (size_t)(row0 + ai * HALF + m * 16) * ldc + col0;
                f32x4 h[2];
#pragma unroll
                for (int n = 0; n < 2; ++n) { const f32x4 g = acc[ai][0][m][n], up = acc[ai][1][m][n];
#pragma unroll
                    for (int e = 0; e < 4; ++e) { const float ex = __builtin_amdgcn_exp2f(g[e] * (-1.4426950408889634f)); h[n][e] = g[e] * up[e] * __builtin_amdgcn_rcpf(1.0f + ex); } }
                u32x4 w; w.x = cvt_pk_bf16(h[0][0], h[0][1]); w.y = cvt_pk_bf16(h[0][2], h[0][3]); w.z = cvt_pk_bf16(h[1][0], h[1][1]); w.w = cvt_pk_bf16(h[1][2], h[1][3]);
                *(u32x4*)rowp = w; }
    }
};
struct EpiLnAff {
    static constexpr bool PERM = true, AFTER_DRAIN = true;
    const float* base; const bf16_t* basebf; float* out; bf16_t* xn; int ldc; const float* gam; const float* bet; float alpha; PanelStats st; unsigned poison;
    __device__ __forceinline__ void fused(f32x4 (&acc)[2][2][4][2], const Unit& u, int wr, int wc, int fr, int fq, PG8_LAS unsigned char* lds, int wid, int lane) const {
        typedef float f32x2v __attribute__((ext_vector_type(2)));
        const PG8_LAS f32x2v* S = (const PG8_LAS f32x2v*)(lds + 8192);
        const int col0 = u.pn * BM + wc * 32 + 8 * fq;
#pragma unroll
        for (int ai = 0; ai < 2; ++ai)
#pragma unroll
            for (int m = 0; m < 4; ++m) { const size_t off = (size_t)(u.pm * BM + ai * HALF + wr * 64 + m * 16 + fr) * ldc + col0;
#pragma unroll
                for (int bj = 0; bj < 2; ++bj) { f32x4 b0, b1;
                    if (basebf) { const u32x4 w = *(const u32x4*)(basebf + off + bj * HALF);
                        b0[0] = __builtin_bit_cast(float, w.x << 16); b0[1] = __builtin_bit_cast(float, w.x & 0xffff0000u); b0[2] = __builtin_bit_cast(float, w.y << 16); b0[3] = __builtin_bit_cast(float, w.y & 0xffff0000u);
                        b1[0] = __builtin_bit_cast(float, w.z << 16); b1[1] = __builtin_bit_cast(float, w.z & 0xffff0000u); b1[2] = __builtin_bit_cast(float, w.w << 16); b1[3] = __builtin_bit_cast(float, w.w & 0xffff0000u); }
                    else { b0 = *(const f32x4*)(base + off + bj * HALF); b1 = *(const f32x4*)(base + off + bj * HALF + 4); }
                    acc[ai][bj][m][0] = b0 * alpha + acc[ai][bj][m][0]; acc[ai][bj][m][1] = b1 * alpha + acc[ai][bj][m][1]; }
                asm volatile("" : "+v"(acc[ai][0][m][0]), "+v"(acc[ai][0][m][1]), "+v"(acc[ai][1][m][0]), "+v"(acc[ai][1][m][1]));
                if (basebf ? (m == 3) : (m & 1)) asm volatile("" ::: "memory"); }
        const bool bad = st.run(acc, u, wr, wc, fr, fq, lds, wid, lane) || poison != 0u;
        const float qnan = __builtin_nanf("");
        f32x4 gv[2][2], bv[2][2];
#pragma unroll
        for (int bj = 0; bj < 2; ++bj)
#pragma unroll
            for (int n = 0; n < 2; ++n) { gv[bj][n] = *(const f32x4*)(gam + col0 + bj * HALF + n * 4); bv[bj][n] = *(const f32x4*)(bet + col0 + bj * HALF + n * 4); }
#pragma unroll
        for (int ai = 0; ai < 2; ++ai)
#pragma unroll
            for (int m = 0; m < 4; ++m) { const int r = ai * HALF + wr * 64 + m * 16 + fr; const f32x2v sr = S[r]; const size_t off = (size_t)(u.pm * BM + r) * ldc + col0;
#pragma unroll
                for (int bj = 0; bj < 2; ++bj) { f32x4 o0 = (acc[ai][bj][m][0] - sr.x) * sr.y * gv[bj][0] + bv[bj][0], o1 = (acc[ai][bj][m][1] - sr.x) * sr.y * gv[bj][1] + bv[bj][1];
                    if (bad) { o0 = (f32x4){qnan, qnan, qnan, qnan}; o1 = o0; }
                    if (out) { *(f32x4*)(out + off + bj * HALF) = o0; *(f32x4*)(out + off + bj * HALF + 4) = o1; }
                    if (xn) { u32x4 w; w.x = cvt_pk_bf16(o0[0], o0[1]); w.y = cvt_pk_bf16(o0[2], o0[3]); w.z = cvt_pk_bf16(o1[0], o1[1]); w.w = cvt_pk_bf16(o1[2], o1[3]); *(u32x4*)(xn + off + bj * HALF) = w; } }
                asm volatile("" ::: "memory"); }
    }
};
}
#include <hip/hip_bf16.h>
#include <cmath>
namespace attn_body {
using bf16=__hip_bfloat16;
using bf16x8=__attribute__((ext_vector_type(8)))short;
using s16x4=__attribute__((ext_vector_type(4)))short;
using f32x16=__attribute__((ext_vector_type(16)))float;
using u32x4=__attribute__((ext_vector_type(4)))unsigned;
using f32x4_t=__attribute__((ext_vector_type(4)))float;
constexpr int BATCH=4,NHEAD=8,SEQ=8192,D=64,DM=1024;
constexpr int NW=8,QBLK=32,QB=QBLK*NW,KVBLK=64,NQB=SEQ/QB;
constexpr int ATTN_PITCH=DM, ATTN_UNIT_ROWS=QB;
__device__ __forceinline__ int crow(int r,int hi){return (r&3)+8*(r>>2)+4*hi;}
#define SBAR() __builtin_amdgcn_sched_barrier(0)
__device__ __forceinline__ void cmask(f32x16&p0,f32x16&p1,int jb,int qrel,int hi){
  const float NEG=-INFINITY; int kb=64*jb+4*hi;
  #pragma unroll
  for(int r=0;r<16;++r){int kv=kb+(r&3)+8*(r>>2); if(kv>qrel)p0[r]=NEG; if(kv+32>qrel)p1[r]=NEG;}
}

constexpr int NSLOT=3, SLOTB=8192;
constexpr int LDS_K=0, LDS_V=NSLOT*SLOTB, LDS_WS=2*NSLOT*SLOTB, LDS_OST=LDS_WS+NW*64*4, LDS_CK=LDS_OST+NW*4096, LDS_BYTES=LDS_CK+SEQ*4;
constexpr float C2=0.125f*1.4426950408889634f;
__device__ __forceinline__ void glds16(const void*gsrc,unsigned lds_dst){unsigned keep;
  asm volatile("s_mov_b32 %0, m0\n\ts_mov_b32 m0, %2\n\ts_nop 0\n\tglobal_load_lds_dwordx4 %1, off\n\ts_mov_b32 m0, %0":"=&s"(keep):"v"(gsrc),"s"(lds_dst):"memory");}
__device__ __forceinline__ float max3f(float a,float b,float c){float r;asm("v_max3_f32 %0, %1, %2, %3":"=v"(r):"v"(a),"v"(b),"v"(c));return r;}
__device__ __forceinline__ float max2f(float a,float b){float r;asm("v_max_f32_e32 %0, %1, %2":"=v"(r):"v"(a),"v"(b));return r;}
__device__ __forceinline__ float fadd_s(float a,float b){float r;asm("v_add_f32_e32 %0, %1, %2":"=v"(r):"v"(a),"v"(b));return r;}
__device__ __forceinline__ float fsub_s(float a,float b){float r;asm("v_sub_f32_e32 %0, %1, %2":"=v"(r):"v"(a),"v"(b));return r;}
typedef float f32x2_t __attribute__((ext_vector_type(2))); typedef __bf16 bf16x2_t __attribute__((ext_vector_type(2)));
__device__ __forceinline__ unsigned cvtpk_s(float lo,float hi){f32x2_t v={lo,hi};bf16x2_t b=__builtin_convertvector(v,bf16x2_t);return __builtin_bit_cast(unsigned,b);}
#define WAIT_BAR(N) asm volatile("s_waitcnt vmcnt(" #N ") lgkmcnt(0)\n\ts_barrier":::"memory")

__device__ __forceinline__ void qkt(f32x16&p0,f32x16&p1,const char*Kslot,const bf16x8*qr,int r32,int hi){
  const char*kb=Kslot+hi*1024+r32*16;
  #pragma unroll
  for(int d0=0;d0<4;++d0){
    const bf16x8 b0=*reinterpret_cast<const bf16x8*>(kb+d0*2048);
    const bf16x8 b1=*reinterpret_cast<const bf16x8*>(kb+d0*2048+512);
    p0=__builtin_amdgcn_mfma_f32_32x32x16_bf16(b0,qr[d0],p0,0,0,0);p1=__builtin_amdgcn_mfma_f32_32x32x16_bf16(b1,qr[d0],p1,0,0,0);}
}
typedef __attribute__((address_space(3))) const char* lds_cptr;
typedef short v4i16_t __attribute__((ext_vector_type(4)));
__device__ __forceinline__ void kload8(bf16x8*kf,lds_cptr kp){
  kf[0]=*(const __attribute__((address_space(3))) bf16x8*)(kp);      kf[1]=*(const __attribute__((address_space(3))) bf16x8*)(kp+512);
  kf[2]=*(const __attribute__((address_space(3))) bf16x8*)(kp+2048); kf[3]=*(const __attribute__((address_space(3))) bf16x8*)(kp+2560);
  kf[4]=*(const __attribute__((address_space(3))) bf16x8*)(kp+4096); kf[5]=*(const __attribute__((address_space(3))) bf16x8*)(kp+4608);
  kf[6]=*(const __attribute__((address_space(3))) bf16x8*)(kp+6144); kf[7]=*(const __attribute__((address_space(3))) bf16x8*)(kp+6656);
}
__device__ __forceinline__ void kload2(bf16x8*kf,lds_cptr kp,int j){ kf[2*j]=*(const __attribute__((address_space(3))) bf16x8*)(kp+j*2048); kf[2*j+1]=*(const __attribute__((address_space(3))) bf16x8*)(kp+j*2048+512); }
__device__ __forceinline__ s16x4 vtr(lds_cptr p){ return __builtin_bit_cast(s16x4,__builtin_amdgcn_ds_read_tr16_b64_v4i16((__attribute__((address_space(3))) v4i16_t*)p)); }
__device__ __forceinline__ float rowmax(const f32x16&p0,const f32x16&p1){
  float a=max3f(p0[0],p0[1],p1[0]),b=max3f(p0[2],p0[3],p1[1]);a=max3f(a,p1[2],p1[3]);
  #pragma unroll
  for(int r=4;r<16;r+=4){a=max3f(a,p0[r],p0[r+1]);b=max3f(b,p0[r+2],p0[r+3]);a=max3f(a,p1[r],p1[r+1]);b=max3f(b,p1[r+2],p1[r+3]);}
  const float m=max2f(a,b);
  auto rr=__builtin_amdgcn_permlane32_swap(__float_as_uint(m),__float_as_uint(m),false,false);
  return max2f(__uint_as_float(rr[0]),__uint_as_float(rr[1]));
}
__device__ __forceinline__ void pv(f32x16*o,int vb,bf16x8 pa0,bf16x8 pa1,bf16x8 pa2,bf16x8 pa3){
  #pragma unroll
  for(int d0=0;d0<2;++d0){s16x4 lo[4],hi[4];
    #pragma unroll
    for(int ks=0;ks<4;++ks){
      asm volatile("ds_read_b64_tr_b16 %0,%1 offset:%c2":"=&v"(lo[ks]):"v"(vb),"i"(d0*4096+ks*1024):"memory");
      asm volatile("ds_read_b64_tr_b16 %0,%1 offset:%c2":"=&v"(hi[ks]):"v"(vb),"i"(d0*4096+ks*1024+512):"memory");}
    asm volatile("s_waitcnt lgkmcnt(0)":::"memory");SBAR();
    #define PK(k) (bf16x8){lo[k][0],lo[k][1],lo[k][2],lo[k][3],hi[k][0],hi[k][1],hi[k][2],hi[k][3]}
    o[d0]=__builtin_amdgcn_mfma_f32_32x32x16_bf16(pa0,PK(0),o[d0],0,0,0);
    o[d0]=__builtin_amdgcn_mfma_f32_32x32x16_bf16(pa1,PK(1),o[d0],0,0,0);
    o[d0]=__builtin_amdgcn_mfma_f32_32x32x16_bf16(pa2,PK(2),o[d0],0,0,0);
    o[d0]=__builtin_amdgcn_mfma_f32_32x32x16_bf16(pa3,PK(3),o[d0],0,0,0);
    #undef PK
  }
}

__device__ __forceinline__ unsigned pack_hilo(float v){ const unsigned hb=cvtpk_s(v,0.f)&0xffffu; const float lo=v-__uint_as_float(hb<<16); return hb|(cvtpk_s(lo,0.f)<<16); }
__device__ __forceinline__ float unpack_hilo(unsigned w){ return __uint_as_float(w<<16)+__uint_as_float(w&0xffff0000u); }
typedef __attribute__((address_space(3))) const f32x4_t* lds_f4ptr;
__device__ __forceinline__ void ldbias_raw(f32x16&c0,f32x16&c1,lds_cptr ckp){
  #pragma unroll
  for(int g=0;g<4;++g){ const f32x4_t a=*(lds_f4ptr)(ckp+g*32), b=*(lds_f4ptr)(ckp+128+g*32);
    c0[4*g]=a[0];c0[4*g+1]=a[1];c0[4*g+2]=a[2];c0[4*g+3]=a[3]; c1[4*g]=b[0];c1[4*g+1]=b[1];c1[4*g+2]=b[2];c1[4*g+3]=b[3]; }
}
__device__ __forceinline__ void ldbias_fin(f32x16&c0,f32x16&c1,float cqm){
  #pragma unroll
  for(int r=0;r<16;++r){ c0[r]=cqm-c0[r]; c1[r]=cqm-c1[r]; }
}
#ifndef ATTN_STORE16
#define ATTN_STORE16(p,v) (*(u32x4*)(p)=(v))
#endif
template<int THRL> __device__ __forceinline__ void attn_unit(int b,int h,int qb,const bf16*Q,const bf16*__restrict__ K,const bf16*__restrict__ V,bf16*O,const float*__restrict__ CS,float skipthr,char*shm,int wave_,unsigned*qctr,unsigned&nxt_,bool lead_){
  const int wid=__builtin_amdgcn_readfirstlane(wave_),lane=mk_lane_id(),tid=wid*64+lane,r32=lane&31,hi=lane>>5;
  const long rowbase=(long)b*SEQ; const int q0=qb*QB;
  const bf16*Qw=Q+(rowbase+q0+wid*QBLK)*DM+h*D;
  const bf16*Kh=K+rowbase*DM+h*D,*Vh=V+rowbase*DM+h*D;
  const unsigned lds0=(unsigned)(uintptr_t)shm;
  float*wsf=(float*)(shm+LDS_WS)+wid*64;
  const bf16*ksrc=Kh+(long)lane*DM+wid*8;
  const bf16*vsrc=Vh+(long)(16*(wid&3)+(lane>>2))*DM+(wid>>2)*32+(lane&3)*8;
  const unsigned kdst=lds0+LDS_K+wid*1024, vdst=lds0+LDS_V+wid*1024;
  #define DMA_K(t,slot) glds16(ksrc+(long)(NT-1-(t))*KVBLK*DM,(unsigned)__builtin_amdgcn_readfirstlane(kdst+(slot)))
  #define DMA_V(t,slot) glds16(vsrc+(long)(NT-1-(t))*KVBLK*DM,(unsigned)__builtin_amdgcn_readfirstlane(vdst+(slot)))
  const int vb0=(int)(lds0+LDS_V)+((lane>>4)&1)*32+(lane&3)*8+(4*hi+((lane&15)>>2))*64;
  const char*Kbase=shm+LDS_K; bf16x8 kf[8];
  const lds_cptr shm3=(lds_cptr)shm; const lds_cptr kp0=shm3+LDS_K+hi*1024+r32*16; const lds_cptr vp0=shm3+LDS_V+((lane>>4)&1)*32+(lane&3)*8+(4*hi+((lane&15)>>2))*64;
  const int NT=(q0+QB)/KVBLK;
  const float*cgl=CS+(long)(b*NHEAD+h)*SEQ; const float cref=cgl[q0];
  f32x4_t cv[4];
  #pragma unroll
  for(int k=0;k<4;++k){ const int idx=tid+512*k; cv[k]=(4*idx<q0+QB)?*reinterpret_cast<const f32x4_t*>(cgl+4*idx):(f32x4_t){0.f,0.f,0.f,0.f}; }
  DMA_K(0,0);DMA_V(0,0);DMA_K(1,SLOTB);
  bf16x8 qr[4];
  #pragma unroll
  for(int d0=0;d0<4;++d0)qr[d0]=*reinterpret_cast<const bf16x8*>(&Qw[(long)r32*DM+d0*16+hi*8]);
  #pragma unroll
  for(int k=0;k<4;++k){ const int idx=tid+512*k; if(4*idx<q0+QB){ const f32x4_t e_=(cref-cv[k])*1.4426950408889634f; *(__attribute__((address_space(3))) u32x4*)(shm3+LDS_CK+16*idx)=(u32x4){pack_hilo(e_[0]),pack_hilo(e_[1]),pack_hilo(e_[2]),pack_hilo(e_[3])}; } }
  const lds_cptr cke=shm3+LDS_CK+4*r32;
  const unsigned qxw=hi?0u:0x3f803f80u; const bf16x8 qext=__builtin_bit_cast(bf16x8,(u32x4){qxw,0u,0u,0u});
  #define KEXT(w) __builtin_bit_cast(bf16x8,(u32x4){(w),0u,0u,0u})
  #define KEW(tile,half) (*(const __attribute__((address_space(3))) unsigned*)(cke+256*(tile)+128*(half)))
  float l_reg=0.f;f32x16 o[2];o[0]=f32x16{};o[1]=f32x16{};
  const int qrel=wid*QBLK+r32;
  #define CMASK(P0,P1,t) do{int jb_=3-(t); if(jb_>=0)cmask(P0,P1,jb_,qrel,hi);}while(0)
  bool resc=false;
  #define START(P0,P1) do{ const float rm=rowmax(P0,P1); resc=false; \
    { const float dl=(rm>-1e30f)?rm:0.f; cqm=fsub_s(cqm,dl);   \
      _Pragma("unroll") for(int r=0;r<16;++r){P0[r]=fsub_s(P0[r],dl);P1[r]=fsub_s(P1[r],dl);} \
      _Pragma("unroll") for(int r=0;r<16;++r)cq16[r]=cqm; asm volatile("":"+v"(cq16)); } \
    _Pragma("unroll") for(int r=0;r<16;++r)P0[r]=__builtin_amdgcn_exp2f(P0[r]); }while(0)
  #define RESC() do{ if(resc){ asm volatile("s_waitcnt lgkmcnt(0)":::"memory"); \
      _Pragma("unroll") for(int d_=0;d_<2;++d_) _Pragma("unroll") for(int r=0;r<16;++r)o[d_][r]*=wsf[crow(r,hi)]; } }while(0)
  f32x16 pA0,pA1,pB0,pB1;
  int sl_prev=0,sl_cur=0,sl_next=SLOTB;
  #define ROT() do{sl_prev=sl_cur;sl_cur=sl_next;sl_next=(sl_next==(NSLOT-1)*SLOTB)?0:sl_next+SLOTB;}while(0)
  DMA_K(2,2*SLOTB);
  WAIT_BAR(3);
  int NS; { int lo_=0,hi_=NT-4; while(lo_<hi_){ const int mid_=(lo_+hi_)>>1; const float cv_=-unpack_hilo(*(const __attribute__((address_space(3))) unsigned*)(shm3+LDS_CK+4*(64*mid_+63))); if(cv_<=skipthr)hi_=mid_; else lo_=mid_+1; }
    NS=__builtin_amdgcn_readfirstlane((NT-lo_+1)&~1); }
  float cqm=-unpack_hilo(*(const __attribute__((address_space(3))) unsigned*)(shm3+LDS_CK+4*(q0+qrel)));
  f32x16 cq16; _Pragma("unroll") for(int r=0;r<16;++r)cq16[r]=cqm; asm volatile("":"+v"(cq16));
  pA0=cq16; pA1=cq16;
  { const unsigned w0_=KEW(NT-1,0),w1_=KEW(NT-1,1); pA0=__builtin_amdgcn_mfma_f32_32x32x16_bf16(KEXT(w0_),qext,pA0,0,0,0); pA1=__builtin_amdgcn_mfma_f32_32x32x16_bf16(KEXT(w1_),qext,pA1,0,0,0); }
  qkt(pA0,pA1,Kbase,qr,r32,hi);asm volatile("s_nop 15\n\ts_nop 7":"+v"(pA0),"+v"(pA1));CMASK(pA0,pA1,0);
  START(pA0,pA1);
  _Pragma("unroll") for(int r=0;r<16;++r)pA1[r]=__builtin_amdgcn_exp2f(pA1[r]);
  WAIT_BAR(0);
  DMA_K(3,0);DMA_V(1,SLOTB);
  ROT();
  kload8(kf,kp0+sl_cur);
  WAIT_BAR(2);
  s16x4 vlo[8],vhi[8]; u32x4 pw0,pw1,pw2,pw3;
  #define PKW(P,B) cvtpk_s(P[B],P[B+1])
  #define PAF(k) __builtin_bit_cast(bf16x8,pw##k)
  #define VFR(i) (bf16x8){vlo[i][0],vlo[i][1],vlo[i][2],vlo[i][3],vhi[i][0],vhi[i][1],vhi[i][2],vhi[i][3]}
  #define PIN(x) asm volatile("":"+v"(x))
  #define MX3(a,b,c) __builtin_fmaxf(__builtin_fmaxf((a),(b)),(c))
  #define GAPA(MF,A0,A1,A2,A3,W0,W1,PW) do{ MF; sacc+=A0; sacc+=A1; sacc+=A2; sacc+=A3; PIN(sacc); W0; W1; PIN(PW); SBAR(); }while(0)
  #define EX(v) __builtin_amdgcn_exp2f(v)
  #define GAPB(MF,X,B) do{ MF; X[B]=EX(X[B]); X[B+1]=EX(X[B+1]); X[B+2]=EX(X[B+2]); X[B+3]=EX(X[B+3]); PIN(X); SBAR(); }while(0)
  #define VRD(i) do{ vlo[i]=vtr(vp_+(((i)>>2)*4096+((i)&3)*1024)); vhi[i]=vtr(vp_+(((i)>>2)*4096+((i)&3)*1024+512)); }while(0)
  #define KRD(G,j) do{ if(G){ kload2(kf,kp0+sl_next,j); SBAR(); } }while(0)
  #define STEP(C0,C1,P0,P1,t,GK,GV,GL) do{ SBAR(); \
    const unsigned kw0_=KEW(NT-1-(t),0),kw1_=KEW(NT-1-(t),1);   \
    const lds_cptr vp_=vp0+sl_prev; \
    VRD(0); SBAR(); float sacc=(P0[0]+P0[1]); \
    GAPA(C0=__builtin_amdgcn_mfma_f32_32x32x16_bf16(kf[0],qr[0],cq16,0,0,0), P0[2],P0[3],P0[4],P0[5],     pw0[0]=PKW(P0,0), pw0[1]=PKW(P0,2), pw0); \
    VRD(4); SBAR(); GAPA(C1=__builtin_amdgcn_mfma_f32_32x32x16_bf16(kf[1],qr[0],cq16,0,0,0), P0[6],P0[7],P0[8],P0[9],     pw0[2]=PKW(P0,4), pw0[3]=PKW(P0,6), pw0); \
    VRD(1); SBAR(); GAPA(C0=__builtin_amdgcn_mfma_f32_32x32x16_bf16(kf[2],qr[1],C0,0,0,0),   P0[10],P0[11],P0[12],P0[13], pw1[0]=PKW(P0,8), pw1[1]=PKW(P0,10), pw1); \
    VRD(5); SBAR(); GAPA(C1=__builtin_amdgcn_mfma_f32_32x32x16_bf16(kf[3],qr[1],C1,0,0,0),   P0[14],P0[15],P1[0],P1[1],   pw1[2]=PKW(P0,12),pw1[3]=PKW(P0,14), pw1); \
    VRD(2); SBAR(); GAPA(C0=__builtin_amdgcn_mfma_f32_32x32x16_bf16(kf[4],qr[2],C0,0,0,0),   P1[2],P1[3],P1[4],P1[5],     pw2[0]=PKW(P1,0), pw2[1]=PKW(P1,2), pw2); \
    VRD(6); SBAR(); GAPA(C1=__builtin_amdgcn_mfma_f32_32x32x16_bf16(kf[5],qr[2],C1,0,0,0),   P1[6],P1[7],P1[8],P1[9],     pw2[2]=PKW(P1,4), pw2[3]=PKW(P1,6), pw2); \
    VRD(3); SBAR(); GAPA(C0=__builtin_amdgcn_mfma_f32_32x32x16_bf16(kf[6],qr[3],C0,0,0,0),   P1[10],P1[11],P1[12],P1[13], pw3[0]=PKW(P1,8), pw3[1]=PKW(P1,10), pw3); \
    VRD(7); SBAR(); GAPA(C1=__builtin_amdgcn_mfma_f32_32x32x16_bf16(kf[7],qr[3],C1,0,0,0),   P1[14],P1[15],0.f,0.f,       pw3[2]=PKW(P1,12),pw3[3]=PKW(P1,14), pw3); \
    C0=__builtin_amdgcn_mfma_f32_32x32x16_bf16(KEXT(kw0_),qext,C0,0,0,0); C1=__builtin_amdgcn_mfma_f32_32x32x16_bf16(KEXT(kw1_),qext,C1,0,0,0); SBAR(); \
    l_reg+=sacc; \
    if(GK){DMA_K((t)+3,sl_cur);} if(GV){DMA_V((t)+1,sl_next);} \
    CMASK(C0,C1,t); \
    { float a=MX3(C0[0],C0[1],C1[0]),b=MX3(C0[2],C0[3],C1[1]); a=MX3(a,C1[2],C1[3]); \
      _Pragma("unroll") for(int r=4;r<16;r+=4){a=MX3(a,C0[r],C0[r+1]);b=MX3(b,C0[r+2],C0[r+3]);a=MX3(a,C1[r],C1[r+1]);b=MX3(b,C1[r+2],C1[r+3]);} \
      float rm=__builtin_fmaxf(a,b); { auto rr=__builtin_amdgcn_permlane32_swap(__float_as_uint(rm),__float_as_uint(rm),false,false); rm=__builtin_fmaxf(__uint_as_float(rr[0]),__uint_as_float(rr[1])); } \
      resc=false; \
      if(__builtin_expect(__any(rm>(float)THRL),0)){ const float dl=__builtin_fmaxf(rm,0.f); cqm-=dl; \
        _Pragma("unroll") for(int r=0;r<16;++r)cq16[r]=cqm; asm volatile("":"+v"(cq16)); \
        _Pragma("unroll") for(int r=0;r<16;++r){C0[r]-=dl;C1[r]-=dl;} \
        const float f=__builtin_amdgcn_exp2f(-dl); l_reg*=f; if(hi==0)wsf[r32]=f; resc=true; } } \
    SBAR(); \
    GAPB(o[0]=__builtin_amdgcn_mfma_f32_32x32x16_bf16(PAF(0),VFR(0),o[0],0,0,0), C0,0); \
    GAPB(o[1]=__builtin_amdgcn_mfma_f32_32x32x16_bf16(PAF(0),VFR(4),o[1],0,0,0), C0,4); \
    KRD(GL,0); GAPB(o[0]=__builtin_amdgcn_mfma_f32_32x32x16_bf16(PAF(1),VFR(1),o[0],0,0,0), C0,8); \
    KRD(GL,1); GAPB(o[1]=__builtin_amdgcn_mfma_f32_32x32x16_bf16(PAF(1),VFR(5),o[1],0,0,0), C0,12); \
    KRD(GL,2); GAPB(o[0]=__builtin_amdgcn_mfma_f32_32x32x16_bf16(PAF(2),VFR(2),o[0],0,0,0), C1,0); \
    KRD(GL,3); GAPB(o[1]=__builtin_amdgcn_mfma_f32_32x32x16_bf16(PAF(2),VFR(6),o[1],0,0,0), C1,4); \
    GAPB(o[0]=__builtin_amdgcn_mfma_f32_32x32x16_bf16(PAF(3),VFR(3),o[0],0,0,0), C1,8); \
    GAPB(o[1]=__builtin_amdgcn_mfma_f32_32x32x16_bf16(PAF(3),VFR(7),o[1],0,0,0), C1,12); \
    }while(0)
  int t=1;
  for(;t+5<NS;t+=2){
    STEP(pB0,pB1,pA0,pA1,t,true,true,true);     WAIT_BAR(2); RESC(); ROT();
    STEP(pA0,pA1,pB0,pB1,t+1,true,true,true);   WAIT_BAR(2); RESC(); ROT();
  }
  #define ENDW(tt) do{ if((tt)+3<NS){WAIT_BAR(2);} else if((tt)+2<NS){WAIT_BAR(1);} else {WAIT_BAR(0);} }while(0)
  for(;t+1<NS;t+=2){
    STEP(pB0,pB1,pA0,pA1,t,(t+3<NS),(t+1<NS),(t+1<NS));       ENDW(t);   RESC(); ROT();
    STEP(pA0,pA1,pB0,pB1,t+1,(t+4<NS),(t+2<NS),(t+2<NS));     ENDW(t+1); RESC(); ROT();
  }
  STEP(pB0,pB1,pA0,pA1,NS-1,false,false,false); RESC();
  { float sacc=pB0[0]+pB0[1]; _Pragma("unroll") for(int r=2;r<16;++r)sacc+=pB0[r]; _Pragma("unroll") for(int r=0;r<16;++r)sacc+=pB1[r]; l_reg+=sacc;
    pw0=(u32x4){PKW(pB0,0),PKW(pB0,2),PKW(pB0,4),PKW(pB0,6)};pw1=(u32x4){PKW(pB0,8),PKW(pB0,10),PKW(pB0,12),PKW(pB0,14)};pw2=(u32x4){PKW(pB1,0),PKW(pB1,2),PKW(pB1,4),PKW(pB1,6)};pw3=(u32x4){PKW(pB1,8),PKW(pB1,10),PKW(pB1,12),PKW(pB1,14)};
    SBAR(); pv(o,vb0+sl_cur,PAF(0),PAF(1),PAF(2),PAF(3)); }
  #undef PKW
  #undef PAF
  #undef VFR
  #undef PIN
  #undef MX3
  #undef GAPA
  #undef GAPB
  #undef EX
  #undef VRD
  #undef KRD
  #undef STEP
  #undef ENDW
  if(lead_)nxt_=atomicAdd(qctr,1u);
  {auto rr=__builtin_amdgcn_permlane32_swap(__float_as_uint(l_reg),__float_as_uint(l_reg),false,false);l_reg=__uint_as_float(rr[0])+__uint_as_float(rr[1]);}
  if(hi==0)wsf[32+r32]=l_reg;asm volatile("s_waitcnt lgkmcnt(0)":::"memory");
  float rli[16];
  #pragma unroll
  for(int r=0;r<16;++r)rli[r]=__builtin_amdgcn_rcpf(wsf[32+crow(r,hi)]);
  bf16*Ow=O+(rowbase+q0+wid*QBLK)*DM+h*D;
  { bf16*stg=(bf16*)(shm+LDS_OST)+wid*2048;
    #pragma unroll
    for(int r=0;r<16;++r){const int orow=crow(r,hi);
      #pragma unroll
      for(int d0=0;d0<2;++d0)stg[orow*64+d0*32+r32]=__float2bfloat16(o[d0][r]*rli[r]);}
    asm volatile("s_waitcnt lgkmcnt(0)":::"memory");
    #pragma unroll
    for(int i=0;i<4;++i){const int row=i*8+(lane>>3),ch=lane&7; const u32x4 v=*(const u32x4*)(stg+row*64+ch*8); ATTN_STORE16(Ow+(long)row*DM+ch*8,v);} }
  asm volatile("s_waitcnt lgkmcnt(0)\n\ts_barrier":::"memory");
  #undef DMA_K
  #undef DMA_V
  #undef CMASK
  #undef START
  #undef RESC
  #undef ROT
}
constexpr int ATTN_LDS_BYTES=LDS_BYTES;
struct AttnTensors { const bf16* Q; const bf16* K; const bf16* V; bf16* O; const float* CS; const unsigned* nrm; unsigned* qctr; };
template<int THRL=8> __device__ __forceinline__ void attn_phase(char*lds,const AttnTensors&T,volatile __attribute__((address_space(3))) unsigned*qw,int wave_){
  const bool lead_=(wave_==0&&mk_lane_id()==0); unsigned nxt_=0u; if(lead_)nxt_=atomicAdd(T.qctr,1u);
  for(;;){
    if(lead_){ *qw=nxt_; }
    asm volatile("s_waitcnt vmcnt(0) lgkmcnt(0)\n\ts_barrier":::"memory");
    const unsigned u=__builtin_amdgcn_readfirstlane(*qw);
    if(u>=(unsigned)(BATCH*NHEAD*NQB))break;
    const int bh=(int)(u&31u),qb=NQB-1-(int)(u>>5);
    const float qp=__uint_as_float(__hip_atomic_load(T.nrm+bh,__ATOMIC_RELAXED,__HIP_MEMORY_SCOPE_AGENT)),kp=__uint_as_float(__hip_atomic_load(T.nrm+32+bh,__ATOMIC_RELAXED,__HIP_MEMORY_SCOPE_AGENT));
    const float skipthr=160.f+4.1f*sqrtf(qp*kp);
    attn_unit<THRL>(bh/NHEAD,bh%NHEAD,qb,T.Q,T.K,T.V,T.O,T.CS,skipthr,lds,wave_,T.qctr,nxt_,lead_);
  }
}
#undef SBAR
#undef WAIT_BAR
}

#include <hip/hip_cooperative_groups.h>
namespace cg = cooperative_groups;
constexpr int NWAVES = 8;
#ifndef MK_N_LAUNCHES
#define MK_N_LAUNCHES 1
#endif
constexpr int NPH = 11;
constexpr int N_LAUNCHES = MK_N_LAUNCHES;
static_assert(N_LAUNCHES == 1 || N_LAUNCHES == NPH, "MK_N_LAUNCHES is 1 or 11");

constexpr int BATCH = 4, SEQ = 8192, D = 1024, M = BATCH * SEQ, NH = 8;
constexpr int EVEN_IN = 3080, NIN0 = 3072, FFH = 2816, NFF = 2 * FFH, NG = 2048;
constexpr float LN_EPS = 1e-5f, ALPHA = 1.4142135623730951f;

constexpr size_t MiB = 1u << 20;
constexpr size_t WS_CTL = 0, CTL_ZERO_BYTES = 1 * MiB;
constexpr size_t WS_X = 1 * MiB;
constexpr size_t WS_CSUM = 5 * MiB, WS_LOGF = 6 * MiB, WS_RSW = 7 * MiB;
constexpr size_t WS_WIN0 = 8 * MiB, WS_WOUT0 = 14 * MiB, WS_WFI0 = 16 * MiB, WS_WFO0 = 27 * MiB, WS_WIN1 = 33 * MiB, WS_WOUT1 = 37 * MiB, WS_WFI1 = 39 * MiB, WS_WFO1 = 50 * MiB;
constexpr size_t WS_XN = 56 * MiB, WS_MIX = 120 * MiB, WS_BIG = 184 * MiB, WS_PART = 376 * MiB, WS_END = 378 * MiB;
constexpr size_t BUF = (size_t)M * D;
constexpr int CW_NRM = 64, CW_QCTR = 192;
constexpr int CW_TMO = 0, CW_CODE = 1, CW_SEAM = 16384, SEAM_BANK = 128 * 64;
static_assert((CW_SEAM + 4 * SEAM_BANK) * 4 <= (int)CTL_ZERO_BYTES, "CTL words inside the memset region");

constexpr int RING_BYTES = 131072, LDS_BYTES = 147456, MISC_OFF = LDS_BYTES - 256;
static_assert(attn_body::ATTN_LDS_BYTES <= RING_BYTES, "attention scratch fits the ring region");

#define LAS __attribute__((address_space(3)))
typedef unsigned short bf16;
typedef unsigned v4u __attribute__((ext_vector_type(4)));
typedef unsigned v2u __attribute__((ext_vector_type(2)));
typedef float f32x4 __attribute__((ext_vector_type(4)));
typedef short bf16x8 __attribute__((ext_vector_type(8)));
typedef float f32x16 __attribute__((ext_vector_type(16)));
#define RLX_AGENT __ATOMIC_RELAXED, __HIP_MEMORY_SCOPE_AGENT
#define LDS_WAIT() asm volatile("s_waitcnt lgkmcnt(0)" ::: "memory")
__device__ __forceinline__ unsigned f2bf(float f) { unsigned u = __builtin_bit_cast(unsigned, f); return (u + 0x7fffu + ((u >> 16) & 1u)) >> 16; }
__device__ __forceinline__ unsigned pk2(float lo, float hi) { return f2bf(lo) | (f2bf(hi) << 16); }
__device__ __forceinline__ float bf2f(unsigned short h) { return __builtin_bit_cast(float, (unsigned)h << 16); }
__device__ __forceinline__ float bflo(unsigned w) { return __builtin_bit_cast(float, w << 16); }
__device__ __forceinline__ float bfhi(unsigned w) { return __builtin_bit_cast(float, w & 0xffff0000u); }

#define XB_TMO      128
#define XB_XCNT(j)  (256  + 64 * (j))
#define XB_XSUB(j)  (1280 + 64 * (j))
#define XB_XGEN(j)  (2304 + 64 * (j))
#define XB_TOP      3328
#define XB_TOPGEN   3392
#define XCD_BAR_WORDS 3456
#define XB_SPIN_CAP (1u << 18)

__device__ __forceinline__ unsigned xb_ld(unsigned* p)              { return __hip_atomic_load(p, __ATOMIC_RELAXED, __HIP_MEMORY_SCOPE_AGENT); }
__device__ __forceinline__ unsigned xb_add(unsigned* p, unsigned v) { return __hip_atomic_fetch_add(p, v, __ATOMIC_RELAXED, __HIP_MEMORY_SCOPE_AGENT); }
__device__ __forceinline__ unsigned xb_xcc_id() { return (unsigned)__builtin_amdgcn_s_getreg((3 << 11) | 20) & 0xFu; }
#define XB_SPIN(cond, bar) do { unsigned _sp = 0; while (cond) { __builtin_amdgcn_s_sleep(1); \
    if ((++_sp & 255u) == 0u) { if (xb_ld(&(bar)[XB_TMO])) break; if (_sp > XB_SPIN_CAP) { atomicAdd(&(bar)[XB_TMO], 1u); break; } } } } while (0)

struct XcdBarrier {
    unsigned* bar; unsigned x;
    volatile LAS unsigned* st;
};

__device__ __forceinline__ XcdBarrier xcd_barrier_post(unsigned* bar, volatile LAS unsigned* st) {
    XcdBarrier b; b.bar = bar; b.x = xb_xcc_id(); b.st = st;
    if (threadIdx.x == 0) (void)xb_add(&bar[XB_XCNT(b.x)], 1u);
    return b;
}
__device__ __forceinline__ void xcd_barrier_complete(unsigned* bar, unsigned x, unsigned& nloc, unsigned& nx) {
    const unsigned G = gridDim.x * gridDim.y * gridDim.z;
    unsigned sum, cnt, mine, sp = 0u;
    for (;;) {
        sum = 0u; cnt = 0u; mine = 0u;
#pragma unroll
        for (unsigned j = 0; j < 16; ++j) { const unsigned c = xb_ld(&bar[XB_XCNT(j)]); sum += c; cnt += (c > 0u) ? 1u : 0u; mine = (j == x) ? c : mine; }
        if (sum == G) break;
        __builtin_amdgcn_s_sleep(1);
        if ((++sp & 255u) == 0u) { if (xb_ld(&bar[XB_TMO])) break; if (sp > XB_SPIN_CAP) { atomicAdd(&bar[XB_TMO], 1u); break; } }
    }
    nloc = mine > 0u ? mine : 1u; nx = cnt > 0u ? cnt : 1u;
}

__device__ __forceinline__ void xcd_barrier(const XcdBarrier& b) {
    asm volatile("s_waitcnt vmcnt(0)" ::: "memory");
    __syncthreads();
    if (threadIdx.x == 0) {
        unsigned* bar = b.bar;
        __builtin_amdgcn_s_waitcnt(0);
        unsigned nloc = b.st[0], nx = b.st[1];
        if (nloc == 0u) { xcd_barrier_complete(bar, b.x, nloc, nx); b.st[0] = nloc; b.st[1] = nx; }
        const unsigned old = xb_add(&bar[XB_XSUB(b.x)], 1u);
        const unsigned gen = old / nloc;
        if (old + 1u == (gen + 1u) * nloc) {
            __builtin_amdgcn_fence(__ATOMIC_RELEASE, "agent");
            asm volatile("s_waitcnt vmcnt(0)" ::: "memory");
            const unsigned og = xb_add(&bar[XB_TOP], 1u);
            const unsigned tg = og / nx;
            if (og + 1u == (tg + 1u) * nx) xb_add(&bar[XB_TOPGEN], 1u);
            else XB_SPIN(xb_ld(&bar[XB_TOPGEN]) == tg, bar);
            __builtin_amdgcn_fence(__ATOMIC_ACQUIRE, "agent");
            xb_add(&bar[XB_XGEN(b.x)], 1u);
            asm volatile("s_waitcnt vmcnt(0)" ::: "memory");
        } else {
            XB_SPIN(xb_ld(&bar[XB_XGEN(b.x)]) == gen, bar);
            __builtin_amdgcn_fence(__ATOMIC_ACQUIRE, "agent");
            asm volatile("s_waitcnt vmcnt(0)" ::: "memory");
        }
    }
    __syncthreads();
}
constexpr int CW_BAR = 4096;
static_assert(CW_BAR + XCD_BAR_WORDS <= 16384, "barrier words below the panel counters");

struct Frame {
    LAS unsigned char* lds; unsigned char* ldsg;
    unsigned* ctl; unsigned char* ws;
    int wave, vcu, G;
};
struct Args { const float* in[17]; float* out; unsigned char* ws; int ph_lo, ph_hi; };
typedef const __attribute__((address_space(4))) Args* kargs_ptr;
__device__ __forceinline__ kargs_ptr kargs() {
#if defined(__HIP_DEVICE_COMPILE__)
    unsigned long long p = (unsigned long long)__builtin_amdgcn_kernarg_segment_ptr(); asm volatile("" : "+s"(p)); return (kargs_ptr)p;
#else
    return nullptr;
#endif
}

__device__ __forceinline__ float wave_sum(float v) {
#pragma unroll
    for (int o = 1; o < 64; o <<= 1) v += __shfl_xor(v, o);
    return v;
}
__device__ __forceinline__ void tr_item(const float* W, int K, int ldw, int srccol0, bf16* WT, int dstrow0, int k0, float scale, LAS float* scr, int lane) {
#pragma unroll 8
    for (int i = 0; i < 32; ++i) { const int kk = 2 * i + (lane >> 5); scr[kk * 33 + (lane & 31)] = W[(size_t)(k0 + kk) * ldw + srccol0 + (lane & 31)] * scale; }
    LDS_WAIT(); asm volatile("" ::: "memory");
    const int c = lane & 7;
#pragma unroll
    for (int j = 0; j < 4; ++j) { const int n = (lane >> 3) + 8 * j; const LAS float* sp = scr + (8 * c) * 33 + n;
        v4u o; o.x = pk2(sp[0 * 33], sp[1 * 33]); o.y = pk2(sp[2 * 33], sp[3 * 33]); o.z = pk2(sp[4 * 33], sp[5 * 33]); o.w = pk2(sp[6 * 33], sp[7 * 33]);
        *(v4u*)(WT + (size_t)(dstrow0 + n) * K + k0 + 8 * c) = o; }
    LDS_WAIT(); asm volatile("" ::: "memory");
}

__device__ __forceinline__ void p0_prologue(Frame& F) {
    LAS float* scr = (LAS float*)(F.lds + F.wave * 16384);
    kargs_ptr KA = kargs(); const int gw = F.vcu * NWAVES + F.wave, NGW = F.G * NWAVES, lane = mk_lane_id();
    constexpr int I_IN0 = 16 * 96, I_OUT = 16 * 32, I_FI = 16 * 176, I_FO = 44 * 32, I_IN1 = 16 * 64;
    constexpr int NITEMS = I_IN0 + 2 * I_OUT + 2 * I_FI + 2 * I_FO + I_IN1;
    unsigned char* ws = F.ws;
    for (int it = gw; it < NITEMS; it += NGW) {
        int r = it;
        if (r < I_IN0) { const int kb = r / 96, n0 = 32 * (r % 96); tr_item(KA->in[1], D, EVEN_IN, n0 < 1536 ? n0 : n0 + 8, (bf16*)(ws + WS_WIN0), n0, 64 * kb, n0 < 512 ? attn_body::C2 : 1.0f, scr, lane); continue; } r -= I_IN0;
        if (r < I_OUT) { const int kb = r / 32, n0 = 32 * (r % 32); tr_item(KA->in[4], D, D, n0, (bf16*)(ws + WS_WOUT0), n0, 64 * kb, 1.0f, scr, lane); continue; } r -= I_OUT;
        if (r < I_OUT) { const int kb = r / 32, n0 = 32 * (r % 32); tr_item(KA->in[10], D, D, n0, (bf16*)(ws + WS_WOUT1), n0, 64 * kb, 1.0f, scr, lane); continue; } r -= I_OUT;
        if (r < 2 * I_FI) { const int l = r / I_FI; r -= l * I_FI; const int kb = r / 176, n0 = 32 * (r % 176); const int src = FFH * ((n0 >> 7) & 1) + 128 * (n0 >> 8) + (n0 & 127);
            tr_item(KA->in[13] + (size_t)l * D * NFF, D, NFF, src, (bf16*)(ws + (l ? WS_WFI1 : WS_WFI0)), n0, 64 * kb, 1.0f, scr, lane); continue; } r -= 2 * I_FI;
        if (r < 2 * I_FO) { const int l = r / I_FO; r -= l * I_FO; const int kb = r / 32, n0 = 32 * (r % 32);
            tr_item(KA->in[14] + (size_t)l * FFH * D, FFH, D, n0, (bf16*)(ws + (l ? WS_WFO1 : WS_WFO0)), n0, 64 * kb, 1.0f, scr, lane); continue; } r -= 2 * I_FO;
        { const int kb = r / 64, n0 = 32 * (r % 64); tr_item(KA->in[5], D, NG, n0, (bf16*)(ws + WS_WIN1), n0, 64 * kb, 1.0f, scr, lane); }
    }
    { v4u* xz = (v4u*)(ws + WS_X); const v4u z4 = (v4u){0u, 0u, 0u, 0u}; for (int i = gw * 64 + lane; i < (int)(4 * MiB / 16); i += NGW * 64) xz[i] = z4; }
    if (gw < 1024) { const float* wr = KA->in[8] + (size_t)gw * 128; const int i = gw & 127; float v = wr[lane] + (i >= 64 ? wr[64 + lane] : 0.f); v = wave_sum(v); if (lane == 0) ((float*)(ws + WS_RSW))[gw] = v; }
    float wf[16][8];
#pragma unroll
    for (int j = 0; j < 4; ++j)
#pragma unroll
        for (int e = 0; e < 4; ++e) { const float* p = KA->in[1] + (size_t)(4 * lane + 256 * j + e) * EVEN_IN + 1536; const f32x4 a = *(const f32x4*)p, b = *(const f32x4*)(p + 4);
            wf[j * 4 + e][0] = a[0]; wf[j * 4 + e][1] = a[1]; wf[j * 4 + e][2] = a[2]; wf[j * 4 + e][3] = a[3]; wf[j * 4 + e][4] = b[0]; wf[j * 4 + e][5] = b[1]; wf[j * 4 + e][6] = b[2]; wf[j * 4 + e][7] = b[3]; }
    const float bfl = KA->in[2][lane & 7];
    bf16* XN = (bf16*)(ws + WS_XN); float* LOGF = (float*)(ws + WS_LOGF);
    for (int m = gw; m < M; m += NGW) {
        const f32x4* xr = (const f32x4*)(KA->in[0] + (size_t)m * D) + lane;
        f32x4 v[4];
#pragma unroll
        for (int j = 0; j < 4; ++j) v[j] = xr[64 * j];
        float a[8];
#pragma unroll
        for (int h = 0; h < 8; ++h) a[h] = 0.f;
#pragma unroll
        for (int j = 0; j < 4; ++j)
#pragma unroll
            for (int e = 0; e < 4; ++e)
#pragma unroll
                for (int h = 0; h < 8; ++h) a[h] += v[j][e] * wf[j * 4 + e][h];
#pragma unroll
        for (int h = 0; h < 8; ++h) a[h] = wave_sum(a[h]);
        unsigned long long* o8 = (unsigned long long*)(XN + (size_t)m * D) + lane;
#pragma unroll
        for (int j = 0; j < 4; ++j) o8[64 * j] = (unsigned long long)pk2(v[j][0], v[j][1]) | ((unsigned long long)pk2(v[j][2], v[j][3]) << 32);
        if (lane < 8) { float z = a[0];
#pragma unroll
            for (int h = 1; h < 8; ++h) z = (lane == h) ? a[h] : z;
            z += bfl;
            const float lf = (z >= 0.f) ? -log1pf(expf(-z)) : z - log1pf(expf(z));
            LOGF[(size_t)((m >> 13) * NH + lane) * SEQ + (m & (SEQ - 1))] = lf; }
    }
}

__device__ __forceinline__ void p1_scan(Frame& F, int bh) {
    const float* lf = (const float*)(F.ws + WS_LOGF) + (size_t)bh * SEQ; float* c = (float*)(F.ws + WS_CSUM) + (size_t)bh * SEQ;
    LAS float* wt = (LAS float*)(F.lds + MISC_OFF + 64); const int lane = mk_lane_id(), tid = F.wave * 64 + lane;
    f32x4 v[4]; float run = 0.f;
#pragma unroll
    for (int j = 0; j < 4; ++j) { v[j] = *(const f32x4*)(lf + 16 * tid + 4 * j);
#pragma unroll
        for (int e = 0; e < 4; ++e) { run += v[j][e]; v[j][e] = run; } }
    float inc = run;
#pragma unroll
    for (int o = 1; o < 64; o <<= 1) { const float t = __shfl_up(inc, o); if (lane >= o) inc += t; }
    if (lane == 63) wt[F.wave] = inc;
    __syncthreads();
    float off = inc - run;
    for (int w = 0; w < F.wave; ++w) off += wt[w];
#pragma unroll
    for (int j = 0; j < 4; ++j) *(f32x4*)(c + 16 * tid + 4 * j) = v[j] + off;
    __syncthreads();
}

__device__ __forceinline__ void p2_conv(Frame& F) {
    const bf16* VB = (const bf16*)(F.ws + WS_BIG) + BUF; const bf16* CH = (const bf16*)(F.ws + WS_BIG) + 2 * BUF; bf16* MIX = (bf16*)(F.ws + WS_MIX);
    const int lane = mk_lane_id(); const float* cw = kargs()->in[3];
    float w0[8], w1[8], w2[8];
#pragma unroll
    for (int e = 0; e < 8; ++e) { w0[e] = cw[8 * lane + e]; w1[e] = cw[512 + 8 * lane + e]; w2[e] = cw[1024 + 8 * lane + e]; }
    for (int rb = F.vcu * NWAVES + F.wave; rb < M / 16; rb += F.G * NWAVES) {
        const int t0 = rb * 16; float z1[8], z2[8];
#pragma unroll
        for (int e = 0; e < 8; ++e) { z1[e] = 0.f; z2[e] = 0.f; }
        if ((t0 & (SEQ - 1)) != 0) {
            const v4u c1 = *(const v4u*)(CH + (size_t)(t0 - 1) * D + 8 * lane), h1 = *(const v4u*)(CH + (size_t)(t0 - 1) * D + 512 + 8 * lane);
            const v4u c2 = *(const v4u*)(CH + (size_t)(t0 - 2) * D + 8 * lane), h2 = *(const v4u*)(CH + (size_t)(t0 - 2) * D + 512 + 8 * lane);
#pragma unroll
            for (int e = 0; e < 4; ++e) { z1[2 * e] = bflo(c1[e]) * bflo(h1[e]); z1[2 * e + 1] = bfhi(c1[e]) * bfhi(h1[e]); z2[2 * e] = bflo(c2[e]) * bflo(h2[e]); z2[2 * e + 1] = bfhi(c2[e]) * bfhi(h2[e]); }
        }
#pragma unroll 8
        for (int r = 0; r < 16; ++r) { const size_t t = (size_t)(t0 + r);
            const v4u cg_ = *(const v4u*)(CH + t * D + 8 * lane), hc = *(const v4u*)(CH + t * D + 512 + 8 * lane), bg = *(const v4u*)(VB + t * D + 512 + 8 * lane);
            float z[8], y[8];
#pragma unroll
            for (int e = 0; e < 4; ++e) { z[2 * e] = bflo(cg_[e]) * bflo(hc[e]); z[2 * e + 1] = bfhi(cg_[e]) * bfhi(hc[e]); }
#pragma unroll
            for (int e = 0; e < 8; ++e) y[e] = w0[e] * z2[e] + w1[e] * z1[e] + w2[e] * z[e];
            v4u o;
#pragma unroll
            for (int e = 0; e < 4; ++e) o[e] = pk2(bflo(bg[e]) * y[2 * e], bfhi(bg[e]) * y[2 * e + 1]);
            *(v4u*)(MIX + t * D + 512 + 8 * lane) = o;
#pragma unroll
            for (int e = 0; e < 8; ++e) { z2[e] = z1[e]; z1[e] = z[e]; } }
    }
}

__device__ __forceinline__ void p7_spatial(Frame& F) {
    const bf16* U = (const bf16*)(F.ws + WS_BIG); const bf16* VT = (const bf16*)(F.ws + WS_BIG) + BUF; bf16* GT = (bf16*)(F.ws + WS_MIX);
    kargs_ptr KA = kargs(); const float* lng = KA->in[6]; const float* lnb = KA->in[7]; const float* wsp = KA->in[8]; const float* bsp = KA->in[9]; const float* rsw = (const float*)(F.ws + WS_RSW);
    LAS unsigned char* Wt = F.lds; LAS unsigned char* Vt = F.lds + 34816;
    LAS float* stat = (LAS float*)(F.lds + 69632);
    LAS float* c1s = (LAS float*)(F.lds + 70656);
    LAS float* stage = (LAS float*)(F.lds + 71680);
    LAS float* red = stage;
    const int lane = mk_lane_id(), wave = F.wave, tid = wave * 64 + lane, li = lane & 31, kh = lane >> 5;
    for (int tb = F.vcu; tb < M / 128; tb += F.G) {
        const size_t tok0 = (size_t)tb * 128;
        if (tid < 128) { const f32x4* pp = (const f32x4*)((const float*)(F.ws + WS_PART) + (tok0 + tid) * 16); float s = 0.f, q = 0.f;
#pragma unroll
            for (int k = 0; k < 4; ++k) { const f32x4 v = pp[k]; s += v[0]; q += v[1]; s += v[2]; q += v[3]; }
            const float mean = s * (1.f / 1024.f), var = fmaxf(q * (1.f / 1024.f) - mean * mean, 0.f);
            stat[tid] = mean; stat[128 + tid] = 1.0f / sqrtf(var + LN_EPS); }
        __syncthreads();
        const int dt = wave & 3, ih = wave >> 2, i0 = 64 * ih, nks = ih ? 8 : 4;
        const int srow = tid >> 2, seg = tid & 3;
        const bool wact = (srow >= 64) || (seg < 2);
        v4u vv[4]; f32x4 wv[8];
#define P7_LOAD(gg) do { const v4u* vsrc_ = (const v4u*)(VT + (size_t)(128 * (gg) + srow) * M + tok0 + 32 * seg); _Pragma("unroll") for (int e = 0; e < 4; ++e) vv[e] = vsrc_[e]; \
            if (wact) { const f32x4* wsrc_ = (const f32x4*)(wsp + (size_t)((gg) * 128 + srow) * 128 + 32 * seg); _Pragma("unroll") for (int e = 0; e < 8; ++e) wv[e] = wsrc_[e]; } } while (0)
        P7_LOAD(0);
        v4u uun[4];
#pragma unroll
        for (int ps = 0; ps < 4; ++ps) uun[ps] = *(const v4u*)(U + (tok0 + 32 * ps + (tid >> 4)) * D + 8 * (tid & 15));
        for (int g = 0; g < 8; ++g) {
            v4u uu4[4];
#pragma unroll
            for (int ps = 0; ps < 4; ++ps) uu4[ps] = uun[ps];
            const int chf = 128 * g + 8 * (tid & 15);
            const f32x4 gl0 = *(const f32x4*)(lng + chf), gl1 = *(const f32x4*)(lng + chf + 4), bl0 = *(const f32x4*)(lnb + chf), bl1 = *(const f32x4*)(lnb + chf + 4);
            float rsv[4], bsvv[4];
#pragma unroll
            for (int ps = 0; ps < 4; ++ps) { rsv[ps] = rsw[g * 128 + 32 * ps + (tid >> 4)]; bsvv[ps] = bsp[g * 128 + 32 * ps + (tid >> 4)]; }
            { const int row = srow;
              float c1p = 0.f;
              if (wact) {
#pragma unroll
                  for (int e = 0; e < 8; ++e) { const f32x4 rr = *(const LAS f32x4*)(stat + 128 + 32 * seg + 4 * e), mm = *(const LAS f32x4*)(stat + 32 * seg + 4 * e); wv[e] = wv[e] * rr;
                      c1p += (wv[e][0] * mm[0] + wv[e][1] * mm[1]) + (wv[e][2] * mm[2] + wv[e][3] * mm[3]); }
#pragma unroll
                  for (int e = 0; e < 4; ++e) { v4u wq; wq.x = pk2(wv[2 * e][0], wv[2 * e][1]); wq.y = pk2(wv[2 * e][2], wv[2 * e][3]); wq.z = pk2(wv[2 * e + 1][0], wv[2 * e + 1][1]); wq.w = pk2(wv[2 * e + 1][2], wv[2 * e + 1][3]);
                      *(LAS v4u*)(Wt + row * 272 + 64 * seg + 16 * e) = wq; } }
              c1p += __shfl_xor(c1p, 1); c1p += __shfl_xor(c1p, 2);
              if (seg == 0) c1s[row] = c1p;
#pragma unroll
              for (int e = 0; e < 4; ++e) *(LAS v4u*)(Vt + row * 272 + 64 * seg + 16 * e) = vv[e]; }
            asm volatile("s_waitcnt lgkmcnt(0)\n\ts_barrier" ::: "memory");
            if (g < 7) { P7_LOAD(g + 1);
#pragma unroll
                for (int ps = 0; ps < 4; ++ps) uun[ps] = *(const v4u*)(U + (tok0 + 32 * ps + (tid >> 4)) * D + 128 * (g + 1) + 8 * (tid & 15)); }
            f32x16 acc[2]; acc[0] = f32x16{}; acc[1] = f32x16{}; float c1[2];
            c1[0] = c1s[i0 + li]; c1[1] = c1s[i0 + 32 + li];
#pragma unroll
            for (int ks = 0; ks < 8; ++ks) if (ks < nks) {
                const bf16x8 vf = *(const LAS bf16x8*)(Vt + (32 * dt + li) * 272 + (16 * ks + 8 * kh) * 2);
#pragma unroll
                for (int it = 0; it < 2; ++it) { const bf16x8 wf = *(const LAS bf16x8*)(Wt + (i0 + 32 * it + li) * 272 + (16 * ks + 8 * kh) * 2);
                    acc[it] = __builtin_amdgcn_mfma_f32_32x32x16_bf16(vf, wf, acc[it], 0, 0, 0); }
            }
#pragma unroll
            for (int it = 0; it < 2; ++it) {
                LAS float* sp = stage + (i0 + 32 * it + li) * 132 + 32 * dt + 4 * kh;
#pragma unroll
                for (int rg = 0; rg < 4; ++rg) { f32x4 o; o[0] = acc[it][4 * rg + 0] - c1[it]; o[1] = acc[it][4 * rg + 1] - c1[it]; o[2] = acc[it][4 * rg + 2] - c1[it]; o[3] = acc[it][4 * rg + 3] - c1[it]; *(LAS f32x4*)(sp + 8 * rg) = o; } }
            asm volatile("s_waitcnt lgkmcnt(0)\n\ts_barrier" ::: "memory");
            { const int chk = tid & 15, ch = 128 * g + 8 * chk;
#pragma unroll
              for (int ps = 0; ps < 4; ++ps) { const int row = 32 * ps + (tid >> 4); const size_t tok = tok0 + row; const float rs = rsv[ps], bsv = bsvv[ps];
                  const v4u uu = uu4[ps];
                  const f32x4 a0 = *(const LAS f32x4*)(stage + row * 132 + 8 * chk), a1 = *(const LAS f32x4*)(stage + row * 132 + 8 * chk + 4);
                  const f32x4 s0 = gl0 * a0 + (bl0 * rs + bsv), s1 = gl1 * a1 + (bl1 * rs + bsv);
                  v4u o; o.x = pk2(bflo(uu.x) * s0[0], bfhi(uu.x) * s0[1]); o.y = pk2(bflo(uu.y) * s0[2], bfhi(uu.y) * s0[3]); o.z = pk2(bflo(uu.z) * s1[0], bfhi(uu.z) * s1[1]); o.w = pk2(bflo(uu.w) * s1[2], bfhi(uu.w) * s1[3]);
                  *(v4u*)(GT + tok * D + ch) = o; } }
            asm volatile("s_waitcnt lgkmcnt(0)\n\ts_barrier" ::: "memory");
        }
        __syncthreads();
    }
}

__device__ __forceinline__ void ln_gemm(Frame& F, const bf16* A, const bf16* Wt, int K, const float* base, const bf16* basebf, float* out, bf16* xn, const float* gam, const float* bet, int bank) {
    const unsigned poison = (__hip_atomic_load(F.ctl + CW_TMO, RLX_AGENT) != 0u);
    if (F.G != 256) return;
#pragma unroll 1
    for (int sub = 0; sub < 2; ++sub) {
        const size_t r0 = (size_t)sub * 16384;
        pg8::Gemm g{A + r0 * K, Wt, 16384, D, K}; pg8::StaticOrder S; S.init(16384, D, F.G, (int)blockIdx.x);
        pg8::PanelStats st{(unsigned*)(F.ws + WS_X + (size_t)bank * MiB + (size_t)sub * 524288), F.ctl + CW_SEAM + bank * SEAM_BANK + sub * 4096, F.ctl + CW_TMO, D / 256, LN_EPS, 0x700u + 16u * bank + sub};
        pg8::EpiLnAff E{base ? base + r0 * D : nullptr, basebf ? basebf + r0 * D : nullptr, out ? out + r0 * D : nullptr, xn ? xn + r0 * D : nullptr, D, gam, bet, ALPHA, st, poison};
        pg8::gemm_phase<pg8::EpiLnAff, pg8::StaticOrder, false, PG8_SP2>(F.lds, g, S, E, F.wave);
        __syncthreads();
    }
}

__global__ void __launch_bounds__(NWAVES * 64, 2) trunk_fwd(Args args) {
    extern __shared__ __attribute__((aligned(16))) unsigned char lds[];
    Frame F;
    F.lds = (LAS unsigned char*)lds; F.ldsg = lds;
    F.wave = __builtin_amdgcn_readfirstlane((int)threadIdx.x >> 6);
    F.G = gridDim.x; { const int bx = blockIdx.x; F.vcu = (F.G % 8 == 0) ? (bx % 8) * (F.G / 8) + bx / 8 : bx; }
    F.ws = args.ws; F.ctl = (unsigned*)(args.ws + WS_CTL);
    unsigned char* ws = args.ws;
    bf16* XN = (bf16*)(ws + WS_XN); bf16* MIX = (bf16*)(ws + WS_MIX); bf16* BIG = (bf16*)(ws + WS_BIG);
    const int lo = args.ph_lo, hi = args.ph_hi;
    { volatile LAS unsigned* misc = (volatile LAS unsigned*)(F.lds + MISC_OFF); if (threadIdx.x < 32) misc[threadIdx.x] = 0u; }
    __syncthreads();
    XcdBarrier bar; bar.bar = F.ctl + CW_BAR; bar.x = 0; bar.st = nullptr;
    if (N_LAUNCHES == 1) bar = xcd_barrier_post(F.ctl + CW_BAR, (volatile LAS unsigned*)(F.lds + MISC_OFF) + 8);
#ifndef PHMASK
#define PHMASK 0x7ffu
#endif
#define IN(k) (((PHMASK >> (k)) & 1u) && lo <= (k) && (k) < hi)
#define SEAM(k) do { if (IN(k) && IN((k) + 1)) { if (hi > NPH) cg::this_grid().sync(); else xcd_barrier(bar); } } while (0)

    if (IN(0)) { p0_prologue(F); __syncthreads(); }
    SEAM(0);
    if (IN(1)) {
        if (F.vcu < BATCH * NH) p1_scan(F, F.vcu);
        pg8::Gemm g{XN, (const bf16*)(ws + WS_WIN0), M, NIN0, D}; pg8::StaticOrder S; S.init(M, NIN0, F.G, (int)blockIdx.x);
        pg8::EpiBf16QK E{BIG, D, D, BUF, F.ctl + CW_NRM};
        pg8::gemm_phase<pg8::EpiBf16QK, pg8::StaticOrder, PG8_ALIGN, PG8_SP2>(F.lds, g, S, E, F.wave);
    }
    SEAM(1);
    if (IN(2)) {
        const attn_body::AttnTensors AT{(const attn_body::bf16*)BIG, (const attn_body::bf16*)(BIG + 512), (const attn_body::bf16*)(BIG + BUF), (attn_body::bf16*)MIX, (const float*)(ws + WS_CSUM), F.ctl + CW_NRM, F.ctl + CW_QCTR};
        attn_body::attn_phase<8>((char*)lds, AT, (volatile LAS unsigned*)(F.lds + MISC_OFF) + 16, F.wave);
        p2_conv(F);
    }
    SEAM(2);
    if (IN(3)) { kargs_ptr KA = kargs(); ln_gemm(F, MIX, (const bf16*)(ws + WS_WOUT0), D, nullptr, XN, nullptr, XN, KA->in[11], KA->in[12], 0); }
    SEAM(3);
    if (IN(4)) {
        pg8::Gemm g{XN, (const bf16*)(ws + WS_WFI0), M, NFF, D}; pg8::StaticOrder S; S.init(M, NFF, F.G, (int)blockIdx.x);
        pg8::EpiSwiGLU E{BIG, FFH};
        pg8::gemm_phase<pg8::EpiSwiGLU, pg8::StaticOrder, PG8_ALIGN, PG8_SP2>(F.lds, g, S, E, F.wave);
    }
    SEAM(4);
    if (IN(5)) { kargs_ptr KA = kargs(); ln_gemm(F, BIG, (const bf16*)(ws + WS_WFO0), FFH, nullptr, XN, nullptr, XN, KA->in[15], KA->in[16], 1); }
    SEAM(5);
    if (IN(6)) {
        { pg8::Gemm g{XN, (const bf16*)(ws + WS_WIN1), M, D, D}; pg8::StaticOrder S; S.init(M, D, F.G, (int)blockIdx.x);
          pg8::EpiBf16<1> E{BIG, D, nullptr, 0, 0, 1.0f};
          pg8::gemm_phase<pg8::EpiBf16<1>, pg8::StaticOrder, PG8_ALIGN, PG8_SP2>(F.lds, g, S, E, F.wave); }
        __syncthreads();
        { pg8::Gemm g{(const bf16*)(ws + WS_WIN1) + (size_t)D * D, XN, D, M, D}; pg8::StaticOrder S; S.init(D, M, F.G, (int)blockIdx.x);
          pg8::EpiBf16VT E{BIG + BUF, M, (float*)(ws + WS_PART)};
          pg8::gemm_phase<pg8::EpiBf16VT, pg8::StaticOrder, PG8_ALIGN, PG8_SP2>(F.lds, g, S, E, F.wave); }
    }
    SEAM(6);
    if (IN(7)) p7_spatial(F);
    SEAM(7);
    if (IN(8)) { kargs_ptr KA = kargs(); ln_gemm(F, MIX, (const bf16*)(ws + WS_WOUT1), D, nullptr, XN, nullptr, XN, KA->in[11] + D, KA->in[12] + D, 2); }
    SEAM(8);
    if (IN(9)) {
        pg8::Gemm g{XN, (const bf16*)(ws + WS_WFI1), M, NFF, D}; pg8::StaticOrder S; S.init(M, NFF, F.G, (int)blockIdx.x);
        pg8::EpiSwiGLU E{BIG, FFH};
        pg8::gemm_phase<pg8::EpiSwiGLU, pg8::StaticOrder, PG8_ALIGN, PG8_SP2>(F.lds, g, S, E, F.wave);
    }
    SEAM(9);
    if (IN(10)) { kargs_ptr KA = kargs(); ln_gemm(F, BIG, (const bf16*)(ws + WS_WFO1), FFH, nullptr, XN, KA->out, nullptr, KA->in[15] + D, KA->in[16] + D, 3); }
#undef IN
#undef SEAM
}

extern "C" void kernel_launch(void* const* d_in, const int* in_sizes, int n_in, void* d_out, int out_size, void* d_ws, size_t ws_size, hipStream_t stream) {
    static int grid = 0;
    if (grid == 0) {
        if (n_in != 17 || in_sizes[0] != M * D || out_size != M * D || ws_size < WS_END) { fprintf(stderr, "kernel_launch: unexpected shapes (n_in %d, in0 %d, out %d, ws %zu)\n", n_in, n_in > 0 ? in_sizes[0] : -1, out_size, ws_size); grid = -1; return; }
        int dev = 0, cus = 0, per_cu = 0;
        if (hipGetDevice(&dev) != hipSuccess || hipDeviceGetAttribute(&cus, hipDeviceAttributeMultiprocessorCount, dev) != hipSuccess) { grid = -1; return; }
        if (hipFuncSetAttribute((const void*)trunk_fwd, hipFuncAttributeMaxDynamicSharedMemorySize, LDS_BYTES) != hipSuccess) { fprintf(stderr, "kernel_launch: hipFuncSetAttribute failed\n"); grid = -1; return; }
        if (hipOccupancyMaxActiveBlocksPerMultiprocessor(&per_cu, (const void*)trunk_fwd, NWAVES * 64, LDS_BYTES) != hipSuccess || per_cu < 1) fprintf(stderr, "kernel_launch: occupancy query reports %d workgroups per CU\n", per_cu);
        (void)hipGetLastError();
        grid = cus;
    }
    if (grid < 0) return;
    if (hipMemsetAsync((char*)d_ws + WS_CTL, 0, CTL_ZERO_BYTES, stream) != hipSuccess) { fprintf(stderr, "kernel_launch: hipMemsetAsync failed\n"); return; }
    Args a{};
    for (int i = 0; i < 17; ++i) a.in[i] = (const float*)d_in[i];
    a.out = (float*)d_out; a.ws = (unsigned char*)d_ws;
    if (N_LAUNCHES == 1) {
        a.ph_lo = 0; a.ph_hi = NPH;
        void* kargs[] = {&a};
        const hipError_t e = hipLaunchCooperativeKernel((const void*)trunk_fwd, dim3(grid), dim3(NWAVES * 64), kargs, LDS_BYTES, stream);
        if (e != hipSuccess) fprintf(stderr, "kernel_launch: cooperative launch failed: %s (grid %d)\n", hipGetErrorString(e), grid);
    } else {
        for (int li = 0; li < NPH; ++li) { a.ph_lo = li; a.ph_hi = li + 1;
            hipLaunchKernelGGL(trunk_fwd, dim3(grid), dim3(NWAVES * 64), LDS_BYTES, stream, a);
            const hipError_t le = hipPeekAtLastError();
            if (le != hipSuccess) { fprintf(stderr, "kernel_launch: launch %d failed: %s\n", li, hipGetErrorName(le)); break; } }
    }
}
```

```cpp
#include <hip/hip_runtime.h>
#include <cstdio>
#include <cstdint>
__device__ __forceinline__ int mk_lane_id() { int l; asm volatile("v_mbcnt_lo_u32_b32 %0, -1, 0\n\tv_mbcnt_hi_u32_b32 %0, -1, %0" : "=v"(l)); return l; }
namespace pg8 {
#define PG8_LAS __attribute__((address_space(3)))
typedef unsigned short bf16_t;
typedef short bf16x8 __attribute__((ext_vector_type(8)));
typedef float f32x4 __attribute__((ext_vector_type(4)));
typedef unsigned u32x4 __attribute__((ext_vector_type(4)));
constexpr int BM = 256, BK = 64, HALF = 128, HTB = HALF * BK * 2  , STAGE_BYTES = 8 * HTB, NXCD = 8, WGM = 8;

__host__ __device__ __forceinline__ int lds_byte(int r, int c) { const int st = (r >> 4) * 2 + (c >> 5), rr = r & 15, cc = c & 31, ob = rr * 64 + cc * 2; return st * 1024 + (ob ^ (((ob >> 9) & 1) << 5)); }
__host__ __device__ __forceinline__ void stage_rc(int b, int& R, int& C) { const int st = b / 1024, sb = b % 1024, swz = sb ^ (((sb >> 9) & 1) << 5); R = (st >> 1) * 16 + swz / 64; C = (st & 1) * 32 + (swz % 64) / 2; }
__host__ __device__ __forceinline__ int perm32(int rho) { const int n = rho >> 4, i = rho & 15; return 8 * (i >> 2) + 4 * n + (i & 3); }

struct Unit { int pm, pn; };
struct Gemm { const bf16_t* A; const bf16_t* Bt; int M, N, K; };

struct StaticOrder {
    int nM, nN, nwg, G, c;
    __host__ __device__ void init(int M, int N, int G_, int c_) { nM = M / BM; nN = N / BM; nwg = nM * nN; G = G_; c = c_; }
    __host__ __device__ bool next(int i, Unit& u) const {
        const long L = (long)i * G + c; if (L >= nwg) return false;
        int wgid = (int)L; { const int q = nwg / NXCD, r = nwg % NXCD, xcd = wgid % NXCD, off = wgid / NXCD; wgid = (xcd < r ? xcd * (q + 1) : r * (q + 1) + (xcd - r) * q) + off; }
        const int nig = WGM * nN, gid = wgid / nig, fm = gid * WGM, gsz = (nM - fm) < WGM ? (nM - fm) : WGM;
        u.pm = fm + ((wgid % nig) % gsz); u.pn = (wgid % nig) / gsz; return true;
    }
    __device__ __forceinline__ void a_ready(const Unit&) const {}
    __device__ __forceinline__ void done(const Unit&) const {}
};

__device__ __forceinline__ unsigned cvt_pk_bf16(float lo, float hi) { unsigned r; asm volatile("v_cvt_pk_bf16_f32 %0, %1, %2" : "=v"(r) : "v"(lo), "v"(hi)); return r; }
typedef float f32x2 __attribute__((ext_vector_type(2)));
__device__ __forceinline__ f32x2 gelu_pk(f32x2 v) {
    const f32x2 av = __builtin_elementwise_abs(v), d = av * 0.2316418882f + 1.0f;
    f32x2 t; t.x = __builtin_amdgcn_rcpf(d.x); t.y = __builtin_amdgcn_rcpf(d.y);
    f32x2 q = t * 0.5307027145f + (-0.7265760135f); q = q * t + 0.7107068705f; q = q * t + (-0.142248368f); q = q * t + 0.127414796f; q = q * t;
    const f32x2 s = (v * v) * (-0.72134752044f);
    f32x2 e; e.x = __builtin_amdgcn_exp2f(s.x); e.y = __builtin_amdgcn_exp2f(s.y);
    const f32x2 m = v * (q * e), r = v - m;
    f32x2 o; o.x = v.x < 0.f ? m.x : r.x; o.y = v.y < 0.f ? m.y : r.y; return o;
}

template <int ACT  > struct EpiBf16 {
    static constexpr bool PERM = true, AFTER_DRAIN = false; static_assert(ACT == 0 || ACT == 1, "EpiBf16: ACT is 0 (none) or 1 (gelu_pk)");
    bf16_t* O; int ldc; const float* bias; int split_cols; size_t split_stride; float scale0;
    __device__ __forceinline__ void operator()(const f32x4 (&acc)[2][2][4][2], const Unit& u, int wr, int wc, int fr, int fq) const {
        const int row0 = u.pm * BM + wr * 64 + fr; int colt = u.pn * BM; bf16_t* base = O;
        float sc = 1.f; if (split_cols) { const int t = colt / split_cols; base += (size_t)t * split_stride; colt -= t * split_cols; if (t == 0) sc = scale0; }
        const int col0 = colt + wc * 32 + 8 * fq, bcol0 = u.pn * BM + wc * 32 + 8 * fq;
        f32x4 bv[2][2];
#pragma unroll
        for (int bj = 0; bj < 2; ++bj)
#pragma unroll
            for (int n = 0; n < 2; ++n) bv[bj][n] = bias ? *(const f32x4*)(bias + bcol0 + bj * HALF + 4 * n) : (f32x4){0.f, 0.f, 0.f, 0.f};
#pragma unroll
        for (int ai = 0; ai < 2; ++ai)
#pragma unroll
            for (int m = 0; m < 4; ++m) { bf16_t* rowp = base + (size_t)(row0 + ai * HALF + m * 16) * ldc + col0;
#pragma unroll
                for (int bj = 0; bj < 2; ++bj) { f32x4 v0 = acc[ai][bj][m][0] + bv[bj][0], v1 = acc[ai][bj][m][1] + bv[bj][1];
                    if (ACT == 1) { f32x2 a = gelu_pk((f32x2){v0[0], v0[1]}), b = gelu_pk((f32x2){v0[2], v0[3]}), c = gelu_pk((f32x2){v1[0], v1[1]}), d = gelu_pk((f32x2){v1[2], v1[3]});
                        v0 = (f32x4){a.x, a.y, b.x, b.y}; v1 = (f32x4){c.x, c.y, d.x, d.y}; }
                    v0 = v0 * sc; v1 = v1 * sc; u32x4 w; w.x = cvt_pk_bf16(v0[0], v0[1]); w.y = cvt_pk_bf16(v0[2], v0[3]); w.z = cvt_pk_bf16(v1[0], v1[1]); w.w = cvt_pk_bf16(v1[2], v1[3]);
                    *(u32x4*)(rowp + bj * HALF) = w; } }
    }
};

struct PanelStats {
    unsigned* xbuf;
    unsigned* cnt;
    unsigned* tmo;
    int ntn; float eps;
    unsigned code;
    __device__ __forceinline__ bool run(const f32x4 (&v)[2][2][4][2], const Unit& u, int wr, int wc, int fr, int fq, PG8_LAS unsigned char* lds, int wid, int lane) const {
        typedef float f32x2v __attribute__((ext_vector_type(2)));
        PG8_LAS f32x2v* P = (PG8_LAS f32x2v*)lds;
        PG8_LAS f32x2v* S = (PG8_LAS f32x2v*)(lds + 8192);
        PG8_LAS unsigned* flag = (PG8_LAS unsigned*)(lds + 8192 + 2048);
#pragma unroll
        for (int ai = 0; ai < 2; ++ai)
#pragma unroll
            for (int m = 0; m < 4; ++m) {
                float s = 0.f;
#pragma unroll
                for (int bj = 0; bj < 2; ++bj)
#pragma unroll
                    for (int n = 0; n < 2; ++n) { const f32x4 x = v[ai][bj][m][n]; s += (x[0] + x[1]) + (x[2] + x[3]); }
                s += __shfl_xor(s, 16); s += __shfl_xor(s, 32);
                const float mw = s * (1.0f / 64.0f); float q = 0.f;
#pragma unroll
                for (int bj = 0; bj < 2; ++bj)
#pragma unroll
                    for (int n = 0; n < 2; ++n) { const f32x4 d = v[ai][bj][m][n] - mw; q += (d[0] * d[0] + d[1] * d[1]) + (d[2] * d[2] + d[3] * d[3]); }
                q += __shfl_xor(q, 16); q += __shfl_xor(q, 32);
                if (fq == 0) P[(ai * HALF + wr * 64 + m * 16 + fr) * 4 + wc] = (f32x2v){mw, q};
            }
        asm volatile("s_waitcnt lgkmcnt(0)" ::: "memory"); __builtin_amdgcn_s_barrier(); asm volatile("" ::: "memory");
        const int row = wid * 32 + (lane & 31);
        unsigned long long* slots = (unsigned long long*)xbuf + (size_t)(u.pm * BM + row) * 4;
        if (wid == 0 && lane == 0) flag[0] = 0u;
        if (lane < 32) {
            const f32x2v a = P[row * 4 + 0], b = P[row * 4 + 1], c = P[row * 4 + 2], d = P[row * 4 + 3];
            const float mt = (a.x + b.x + c.x + d.x) * 0.25f;
            const float da = a.x - mt, db = b.x - mt, dc = c.x - mt, dd = d.x - mt;
            const float m2 = (a.y + b.y) + (c.y + d.y) + 64.0f * ((da * da + db * db) + (dc * dc + dd * dd));
            __hip_atomic_store(slots + u.pn, ((unsigned long long)(__float_as_uint(m2) | 1u) << 32) | __float_as_uint(mt), __ATOMIC_RELAXED, __HIP_MEMORY_SCOPE_AGENT);
        }
        if (lane < 32) {
            unsigned long long w[4]; unsigned spins = 0u; bool dead = false;
            for (;;) {
                bool all = true;
#pragma unroll
                for (int t = 0; t < 4; ++t) { w[t] = (t < ntn) ? __hip_atomic_load(slots + t, __ATOMIC_RELAXED, __HIP_MEMORY_SCOPE_AGENT) : 1ull; all = all && (w[t] != 0ull); }
#if defined(BROKEN_EXCHANGE_NO_WAIT)
                break;
#endif
                if (all) break;
                if (++spins > (1u << 16)) { dead = true; break; }
                __builtin_amdgcn_s_sleep(2);
            }
            if (dead) { unsigned expect = 0u; __hip_atomic_compare_exchange_strong(tmo + 1, &expect, code | (unsigned)(u.pm & 0xff), __ATOMIC_RELAXED, __ATOMIC_RELAXED, __HIP_MEMORY_SCOPE_AGENT);
                        __hip_atomic_store(tmo, 1u, __ATOMIC_RELAXED, __HIP_MEMORY_SCOPE_AGENT); flag[0] = 1u; }
            float mt[4], m2[4]; float ms = 0.f;
#pragma unroll
            for (int t = 0; t < 4; ++t) { if (t < ntn) { mt[t] = __uint_as_float((unsigned)w[t]); m2[t] = __uint_as_float((unsigned)(w[t] >> 32)); } else { mt[t] = 0.f; m2[t] = 0.f; } ms += mt[t]; }
            const float mean = ms / (float)ntn; float q = 0.f;
#pragma unroll
            for (int t = 0; t < 4; ++t) if (t < ntn) { const float dm = mt[t] - mean; q += m2[t] + 256.0f * dm * dm; }
            S[row] = (f32x2v){mean, 1.0f / sqrtf(q / (256.0f * (float)ntn) + eps)};
        }
        asm volatile("s_waitcnt vmcnt(0) lgkmcnt(0)" ::: "memory"); __builtin_amdgcn_s_barrier(); asm volatile("" ::: "memory");
        const bool bad = flag[0] != 0u;
        return bad;
    }
};
struct EpiLnRes {
    static constexpr bool PERM = false, AFTER_DRAIN = true;
    const float* base; float* out; int ldc; const float* bias; PanelStats st; unsigned poison;
    __device__ __forceinline__ void fused(f32x4 (&acc)[2][2][4][2], const Unit& u, int wr, int wc, int fr, int fq, PG8_LAS unsigned char* lds, int wid, int lane) const {
        typedef float f32x2v __attribute__((ext_vector_type(2)));
        const PG8_LAS f32x2v* S = (const PG8_LAS f32x2v*)(lds + 8192);
        const int col0 = u.pn * BM + wc * 32 + 4 * fq;
#pragma unroll
        for (int bj = 0; bj < 2; ++bj)
#pragma unroll
            for (int n = 0; n < 2; ++n) { const f32x4 bv = bias ? *(const f32x4*)(bias + col0 + bj * HALF + n * 16) : (f32x4){0.f, 0.f, 0.f, 0.f};
#pragma unroll
                for (int ai = 0; ai < 2; ++ai)
#pragma unroll
                    for (int m = 0; m < 4; ++m) acc[ai][bj][m][n] += bv; }
        f32x4 pre[4][2][2];
#pragma unroll
        for (int m = 0; m < 4; ++m) { const size_t off = (size_t)(u.pm * BM + wr * 64 + m * 16 + fr) * ldc + col0;
#pragma unroll
            for (int bj = 0; bj < 2; ++bj)
#pragma unroll
                for (int n = 0; n < 2; ++n) pre[m][bj][n] = *(const f32x4*)(base + off + bj * HALF + n * 16); }
        const bool bad = st.run(acc, u, wr, wc, fr, fq, lds, wid, lane) || poison != 0u;
        const float qnan = __builtin_nanf("");
#pragma unroll
        for (int ai = 0; ai < 2; ++ai)
#pragma unroll
            for (int m = 0; m < 4; ++m) { const int r = ai * HALF + wr * 64 + m * 16 + fr; const f32x2v sr = S[r]; const size_t off = (size_t)(u.pm * BM + r) * ldc + col0;
#pragma unroll
                for (int bj = 0; bj < 2; ++bj)
#pragma unroll
                    for (int n = 0; n < 2; ++n) { const f32x4 bs = ai == 0 ? pre[m][bj][n] : *(const f32x4*)(base + off + bj * HALF + n * 16); f32x4 o = bs + (acc[ai][bj][m][n] - sr.x) * sr.y;
                        if (bad) o = (f32x4){qnan, qnan, qnan, qnan}; *(f32x4*)(out + off + bj * HALF + n * 16) = o; }
                if (m & 1) asm volatile("" ::: "memory"); }
    }
};
struct EpiLnResLn {
    static constexpr bool PERM = false, AFTER_DRAIN = true;
    const float* base; float* out; bf16_t* xn; int ldc; const float* bias; PanelStats st1, st2; unsigned poison;
    __device__ __forceinline__ void fused(f32x4 (&acc)[2][2][4][2], const Unit& u, int wr, int wc, int fr, int fq, PG8_LAS unsigned char* lds, int wid, int lane) const {
        typedef float f32x2v __attribute__((ext_vector_type(2))); typedef unsigned u32x2v __attribute__((ext_vector_type(2)));
        const PG8_LAS f32x2v* S = (const PG8_LAS f32x2v*)(lds + 8192);
        const int col0 = u.pn * BM + wc * 32 + 4 * fq;
#pragma unroll
        for (int bj = 0; bj < 2; ++bj)
#pragma unroll
            for (int n = 0; n < 2; ++n) { const f32x4 bv = bias ? *(const f32x4*)(bias + col0 + bj * HALF + n * 16) : (f32x4){0.f, 0.f, 0.f, 0.f};
#pragma unroll
                for (int ai = 0; ai < 2; ++ai)
#pragma unroll
                    for (int m = 0; m < 4; ++m) acc[ai][bj][m][n] += bv; }
        bool bad = st1.run(acc, u, wr, wc, fr, fq, lds, wid, lane) || poison != 0u;
        const float qnan = __builtin_nanf("");
#pragma unroll
        for (int ai = 0; ai < 2; ++ai)
#pragma unroll
            for (int m = 0; m < 4; ++m) { const int r = ai * HALF + wr * 64 + m * 16 + fr; const f32x2v sr = S[r]; const size_t off = (size_t)(u.pm * BM + r) * ldc + col0;
#pragma unroll
                for (int bj = 0; bj < 2; ++bj)
#pragma unroll
                    for (int n = 0; n < 2; ++n) { const f32x4 bs = *(const f32x4*)(base + off + bj * HALF + n * 16); acc[ai][bj][m][n] = bs + (acc[ai][bj][m][n] - sr.x) * sr.y; }
                asm volatile("" : "+v"(acc[ai][0][m][0]), "+v"(acc[ai][0][m][1]), "+v"(acc[ai][1][m][0]), "+v"(acc[ai][1][m][1]));
                if (m & 1) asm volatile("" ::: "memory"); }
        const bool bad1 = bad;
        bad = st2.run(acc, u, wr, wc, fr, fq, lds, wid, lane) || bad;
#pragma unroll
        for (int ai = 0; ai < 2; ++ai)
#pragma unroll
            for (int m = 0; m < 4; ++m) { const int r = ai * HALF + wr * 64 + m * 16 + fr; const f32x2v sr = S[r]; const size_t off = (size_t)(u.pm * BM + r) * ldc + col0;
#pragma unroll
                for (int bj = 0; bj < 2; ++bj)
#pragma unroll
                    for (int n = 0; n < 2; ++n) { const f32x4 x1 = acc[ai][bj][m][n]; *(f32x4*)(out + off + bj * HALF + n * 16) = bad1 ? (f32x4){qnan, qnan, qnan, qnan} : x1;
                        const f32x4 o = (x1 - sr.x) * sr.y; u32x2v w; w.x = cvt_pk_bf16(o[0], o[1]); w.y = cvt_pk_bf16(o[2], o[3]);
                        if (bad) { w.x = 0x7fc07fc0u; w.y = 0x7fc07fc0u; } *(u32x2v*)(xn + off + bj * HALF + n * 16) = w; }
                asm volatile("" ::: "memory"); }
    }
};

template <class Epi, class Sched, bool ALIGN_EPI = false, bool SP2 = false>
__device__ __forceinline__ void gemm_phase(PG8_LAS unsigned char* lds, const Gemm g, const Sched& S, const Epi& E, int wave_) {
    const int wid = __builtin_amdgcn_readfirstlane(wave_), lane = mk_lane_id(), tid = wid * 64 + lane, wr = wid >> 2, wc = wid & 3, fr = lane & 15, fq = lane >> 4;
    const int K = g.K, nt = K / BK;
    unsigned voffA[2], voffB[2];
#pragma unroll
    for (int i = 0; i < 2; ++i) { int R, C; stage_rc(tid * 16 + i * 8192, R, C); const int Rb = Epi::PERM ? ((R & ~31) + perm32(R & 31)) : R;
        voffA[i] = (unsigned)(R * K + C) * 2u; voffB[i] = (unsigned)(Rb * K + C) * 2u; }
    const size_t kstep = (size_t)(BK * 2);
    const size_t hstep = (size_t)HALF * K * 2;
    const size_t tstep = 2 * hstep;
    const unsigned ldsw = (unsigned)wid * 1024u;
    const int aoff = lds_byte(wr * 64 + fr, fq * 8), boff = lds_byte(wc * 32 + fr, fq * 8);
#define PG8_SA(b, h) (((b) * 2 + (h)) * HTB)
#define PG8_SB(b, h) ((4 + (b) * 2 + (h)) * HTB)
#define PG8_STAGE(bufoff, gbase, voff) do { _Pragma("unroll") for (int _i = 0; _i < 2; ++_i) \
        __builtin_amdgcn_global_load_lds((const unsigned*)((const char*)(gbase) + (voff)[_i]), (PG8_LAS unsigned*)(lds + (bufoff) + ldsw + _i * 8192), 16, 0, 0); } while (0)
#define PG8_LDA(dst, b, h) do { _Pragma("unroll") for (int m = 0; m < 4; ++m) _Pragma("unroll") for (int k = 0; k < 2; ++k) dst[m][k] = *(const PG8_LAS bf16x8*)(lds + PG8_SA(b, h) + aoff + m * 2048 + k * 1024); } while (0)
#define PG8_LDB(dst, b, h) do { _Pragma("unroll") for (int n = 0; n < 2; ++n) _Pragma("unroll") for (int k = 0; k < 2; ++k) dst[n][k] = *(const PG8_LAS bf16x8*)(lds + PG8_SB(b, h) + boff + n * 2048 + k * 1024); } while (0)
#define PG8_MMA(ai, bj, At, Bt) do { __builtin_amdgcn_s_setprio(1); _Pragma("unroll") for (int m = 0; m < 4; ++m) _Pragma("unroll") for (int n = 0; n < 2; ++n) _Pragma("unroll") for (int k = 0; k < 2; ++k) \
        acc[ai][bj][m][n] = __builtin_amdgcn_mfma_f32_16x16x32_bf16(Bt[n][k], At[m][k], acc[ai][bj][m][n], 0, 0, 0); __builtin_amdgcn_s_setprio(0); } while (0)
#define PG8_WAIT_V(n) asm volatile("s_waitcnt vmcnt(" #n ")" ::: "memory")
#define PG8_WAIT_L(n) asm volatile("s_waitcnt lgkmcnt(" #n ")" ::: "memory")
#define PG8_BAR __builtin_amdgcn_s_barrier()
#define PG8_SCHED __builtin_amdgcn_sched_barrier(0)
    Unit cur, nxt; int ui = 0;
    if (!S.next(0, cur)) return;
    f32x4 acc[2][2][4][2];
#pragma unroll
    for (int a = 0; a < 2; ++a)
#pragma unroll
        for (int b = 0; b < 2; ++b)
#pragma unroll
            for (int m = 0; m < 4; ++m)
#pragma unroll
                for (int n = 0; n < 2; ++n) acc[a][b][m][n] = (f32x4){0.f, 0.f, 0.f, 0.f};
    bf16x8 At[4][2], B0[2][2], B1[2][2];
    const char* cA = (const char*)g.A + (size_t)cur.pm * tstep; const char* cB = (const char*)g.Bt + (size_t)cur.pn * tstep;
    S.a_ready(cur);
    if constexpr (SP2) {
        PG8_STAGE(PG8_SB(0, 0), cB, voffB); PG8_STAGE(PG8_SB(0, 1), cB + hstep, voffB); PG8_STAGE(PG8_SA(0, 0), cA, voffA); PG8_STAGE(PG8_SA(0, 1), cA + hstep, voffA);
        if (wr == 1) PG8_BAR;
        PG8_WAIT_V(2); PG8_BAR;
        PG8_STAGE(PG8_SB(1, 0), cB + kstep, voffB); PG8_STAGE(PG8_SA(1, 0), cA + kstep, voffA); PG8_STAGE(PG8_SB(1, 1), cB + hstep + kstep, voffB);
        PG8_WAIT_V(6); PG8_BAR;
    } else {
        PG8_STAGE(PG8_SB(0, 0), cB, voffB); PG8_STAGE(PG8_SA(0, 0), cA, voffA); PG8_STAGE(PG8_SB(0, 1), cB + hstep, voffB); PG8_STAGE(PG8_SA(0, 1), cA + hstep, voffA);
        if (wr == 1) PG8_BAR;
        PG8_WAIT_V(4); PG8_BAR;
        PG8_STAGE(PG8_SB(1, 0), cB + kstep, voffB); PG8_STAGE(PG8_SA(1, 0), cA + kstep, voffA); PG8_STAGE(PG8_SB(1, 1), cB + hstep + kstep, voffB);
        PG8_WAIT_V(6); PG8_BAR;
    }
    for (;;) {
        const bool has_next = S.next(ui + 1, nxt);
        const char* nA = has_next ? (const char*)g.A + (size_t)nxt.pm * tstep : cA; const char* nB = has_next ? (const char*)g.Bt + (size_t)nxt.pn * tstep : cB;
        for (int t = 0; t < nt; t += 2) {
            const bool last = (t == nt - 2);
            const char* a1 = cA + (size_t)(t + 1) * kstep;
            const char* a2 = last ? nA : cA + (size_t)(t + 2) * kstep; const char* b2 = last ? nB : cB + (size_t)(t + 2) * kstep;
            const char* a3 = a2 + kstep; const char* b3 = b2 + kstep;
            if (last && has_next) S.a_ready(nxt);
            if constexpr (SP2) {
            PG8_LDB(B0, 0, 0); PG8_LDB(B1, 0, 1); PG8_SCHED; PG8_LDA(At, 0, 0); PG8_STAGE(PG8_SA(1, 1), a1 + hstep, voffA);
            PG8_WAIT_V(8); PG8_WAIT_L(0); PG8_BAR; PG8_MMA(0, 0, At, B0); PG8_MMA(0, 1, At, B1); PG8_BAR; PG8_SCHED;
            PG8_LDA(At, 0, 1); PG8_STAGE(PG8_SB(0, 0), b2, voffB); PG8_STAGE(PG8_SB(0, 1), b2 + hstep, voffB); PG8_STAGE(PG8_SA(0, 0), a2, voffA);
            PG8_WAIT_V(8); PG8_WAIT_L(0); PG8_BAR; PG8_MMA(1, 0, At, B0); PG8_MMA(1, 1, At, B1); PG8_BAR; PG8_SCHED;
            PG8_LDB(B0, 1, 0); PG8_LDB(B1, 1, 1); PG8_SCHED; PG8_LDA(At, 1, 0); PG8_STAGE(PG8_SA(0, 1), a2 + hstep, voffA);
            PG8_WAIT_V(8); PG8_WAIT_L(0); PG8_BAR; PG8_MMA(0, 0, At, B0); PG8_MMA(0, 1, At, B1); PG8_BAR; PG8_SCHED;
            PG8_LDA(At, 1, 1); PG8_STAGE(PG8_SB(1, 0), b3, voffB); PG8_STAGE(PG8_SB(1, 1), b3 + hstep, voffB); PG8_STAGE(PG8_SA(1, 0), a3, voffA);
            PG8_WAIT_V(8); PG8_WAIT_L(0); PG8_BAR; PG8_MMA(1, 0, At, B0); PG8_MMA(1, 1, At, B1); PG8_BAR; PG8_SCHED;
            } else {
            PG8_LDB(B0, 0, 0); PG8_SCHED; PG8_LDA(At, 0, 0); PG8_STAGE(PG8_SA(1, 1), a1 + hstep, voffA);
            PG8_WAIT_L(8); PG8_BAR; PG8_WAIT_L(0); PG8_MMA(0, 0, At, B0); PG8_BAR; PG8_SCHED;
            PG8_LDB(B1, 0, 1); PG8_STAGE(PG8_SB(0, 0), b2, voffB);
            PG8_BAR; PG8_WAIT_L(0); PG8_MMA(0, 1, At, B1); PG8_BAR;
            PG8_LDA(At, 0, 1); PG8_STAGE(PG8_SA(0, 0), a2, voffA);
            PG8_BAR; PG8_WAIT_L(0); PG8_MMA(1, 0, At, B0); PG8_BAR; PG8_SCHED;
            PG8_STAGE(PG8_SB(0, 1), b2 + hstep, voffB);
            PG8_WAIT_V(6); PG8_BAR; PG8_MMA(1, 1, At, B1); PG8_BAR;
            PG8_LDB(B0, 1, 0); PG8_SCHED; PG8_LDA(At, 1, 0); PG8_STAGE(PG8_SA(0, 1), a2 + hstep, voffA);
            PG8_WAIT_L(8); PG8_BAR; PG8_WAIT_L(0); PG8_MMA(0, 0, At, B0); PG8_BAR; PG8_SCHED;
            PG8_LDB(B1, 1, 1); PG8_STAGE(PG8_SB(1, 0), b3, voffB);
            PG8_BAR; PG8_WAIT_L(0); PG8_MMA(0, 1, At, B1); PG8_BAR;
            PG8_LDA(At, 1, 1); PG8_STAGE(PG8_SA(1, 0), a3, voffA);
            PG8_BAR; PG8_WAIT_L(0); PG8_MMA(1, 0, At, B0); PG8_BAR; PG8_SCHED;
            PG8_STAGE(PG8_SB(1, 1), b3 + hstep, voffB);
            PG8_WAIT_V(6); PG8_BAR; PG8_MMA(1, 1, At, B1); PG8_BAR;
            }
        }
        if constexpr (ALIGN_EPI) { if (wr == 0) PG8_BAR; }
        if constexpr (!Epi::AFTER_DRAIN) { E(acc, cur, wr, wc, fr, fq); S.done(cur); }
        if (!has_next) break;
#pragma unroll
        for (int a = 0; a < 2; ++a)
#pragma unroll
            for (int b = 0; b < 2; ++b)
#pragma unroll
                for (int m = 0; m < 4; ++m)
#pragma unroll
                    for (int n = 0; n < 2; ++n) acc[a][b][m][n] = (f32x4){0.f, 0.f, 0.f, 0.f};
        cur = nxt; cA = nA; cB = nB; ++ui;
        if constexpr (ALIGN_EPI) { if (wr == 1) PG8_BAR; }
    }
    PG8_WAIT_V(0);
    if constexpr (!ALIGN_EPI) { if (wr == 0) PG8_BAR; }
    PG8_BAR;
    if constexpr (Epi::AFTER_DRAIN) { E.fused(acc, cur, wr, wc, fr, fq, lds, wid, lane); S.done(cur); }
#undef PG8_SA
#undef PG8_SB
#undef PG8_STAGE
#undef PG8_LDA
#undef PG8_LDB
#undef PG8_MMA
#undef PG8_WAIT_V
#undef PG8_WAIT_L
#undef PG8_BAR
#undef PG8_SCHED
}
}


namespace pg8 {
struct EpiBf16QK {
    static constexpr bool PERM = true, AFTER_DRAIN = false;
    bf16_t* O; int ldc; int split_cols; size_t split_stride; unsigned* nrm;
    __device__ __forceinline__ void operator()(const f32x4 (&acc)[2][2][4][2], const Unit& u, int wr, int wc, int fr, int fq) const {
        const int row0 = u.pm * BM + wr * 64 + fr; int colt = u.pn * BM; bf16_t* base = O;
        { const int t = colt / split_cols; base += (size_t)t * split_stride; colt -= t * split_cols; }
        const int col0 = colt + wc * 32 + 8 * fq;
        float pmax[2] = {0.f, 0.f};
#pragma unroll
        for (int ai = 0; ai < 2; ++ai)
#pragma unroll
            for (int m = 0; m < 4; ++m) { bf16_t* rowp = base + (size_t)(row0 + ai * HALF + m * 16) * ldc + col0;
#pragma unroll
                for (int bj = 0; bj < 2; ++bj) { const f32x4 v0 = acc[ai][bj][m][0], v1 = acc[ai][bj][m][1];
                    u32x4 w; w.x = cvt_pk_bf16(v0[0], v0[1]); w.y = cvt_pk_bf16(v0[2], v0[3]); w.z = cvt_pk_bf16(v1[0], v1[1]); w.w = cvt_pk_bf16(v1[2], v1[3]);
                    *(u32x4*)(rowp + bj * HALF) = w;
                    if (u.pn < 4) { float ss = (v0[0] * v0[0] + v0[1] * v0[1]) + (v0[2] * v0[2] + v0[3] * v0[3]) + (v1[0] * v1[0] + v1[1] * v1[1]) + (v1[2] * v1[2] + v1[3] * v1[3]);
                        ss += __shfl_xor(ss, 16); ss += __shfl_xor(ss, 32); pmax[bj] = fmaxf(pmax[bj], ss); } } }
        if (u.pn < 4) {
#pragma unroll
            for (int bj = 0; bj < 2; ++bj) { float v = pmax[bj];
#pragma unroll
                for (int o = 1; o < 16; o <<= 1) v = fmaxf(v, __shfl_xor(v, o));
                if (fr == 0 && fq == 0) atomicMax(nrm + (u.pn >> 1) * 32 + (u.pm >> 5) * 8 + 4 * (u.pn & 1) + 2 * bj + (wc >> 1), __float_as_uint(v * 1.02f)); }
        }
    }
};
}

namespace pg8 {
struct EpiBf16VT {
    static constexpr bool PERM = true, AFTER_DRAIN = false;
    bf16_t* O; int ldc; float* part;
    __device__ __forceinline__ void operator()(const f32x4 (&acc)[2][2][4][2], const Unit& u, int wr, int wc, int fr, int fq) const {
        const int row0 = u.pm * BM + wr * 64 + fr, col0 = u.pn * BM + wc * 32 + 8 * fq;
#pragma unroll
        for (int bj = 0; bj < 2; ++bj) {
            float ps[8], pq[8];
#pragma unroll
            for (int e = 0; e < 8; ++e) { ps[e] = 0.f; pq[e] = 0.f; }
#pragma unroll
            for (int ai = 0; ai < 2; ++ai)
#pragma unroll
                for (int m = 0; m < 4; ++m) { bf16_t* rowp = O + (size_t)(row0 + ai * HALF + m * 16) * ldc + col0;
                    f32x4 v0 = acc[ai][bj][m][0], v1 = acc[ai][bj][m][1];
                    { f32x2 a = gelu_pk((f32x2){v0[0], v0[1]}), b = gelu_pk((f32x2){v0[2], v0[3]}), c = gelu_pk((f32x2){v1[0], v1[1]}), d = gelu_pk((f32x2){v1[2], v1[3]});
                      v0 = (f32x4){a.x, a.y, b.x, b.y}; v1 = (f32x4){c.x, c.y, d.x, d.y}; }
#pragma unroll
                    for (int e = 0; e < 4; ++e) { ps[e] += v0[e]; pq[e] += v0[e] * v0[e]; ps[4 + e] += v1[e]; pq[4 + e] += v1[e] * v1[e]; }
                    u32x4 w; w.x = cvt_pk_bf16(v0[0], v0[1]); w.y = cvt_pk_bf16(v0[2], v0[3]); w.z = cvt_pk_bf16(v1[0], v1[1]); w.w = cvt_pk_bf16(v1[2], v1[3]);
                    *(u32x4*)(rowp + bj * HALF) = w; }
            { const bool b3 = (fr & 8) != 0, b2 = (fr & 4) != 0, b1 = (fr & 2) != 0, b0 = (fr & 1) != 0;
              float t8[8], t4[4], t2[2];
#pragma unroll
              for (int i = 0; i < 8; ++i) { const float keep = b3 ? pq[i] : ps[i], send = b3 ? ps[i] : pq[i]; t8[i] = keep + __shfl_xor(send, 8); }
#pragma unroll
              for (int i = 0; i < 4; ++i) { const float keep = b2 ? t8[4 + i] : t8[i], send = b2 ? t8[i] : t8[4 + i]; t4[i] = keep + __shfl_xor(send, 4); }
#pragma unroll
              for (int i = 0; i < 2; ++i) { const float keep = b1 ? t4[2 + i] : t4[i], send = b1 ? t4[i] : t4[2 + i]; t2[i] = keep + __shfl_xor(send, 2); }
              const float t1 = (b0 ? t2[1] : t2[0]) + __shfl_xor(b0 ? t2[0] : t2[1], 1);
              const int e = (fr & 7);
              part[((size_t)(col0 + bj * HALF + e) * 8 + 2 * u.pm + wr) * 2 + (b3 ? 1 : 0)] = t1; }
        }
    }
};
}

#ifndef PG8_SP2
#define PG8_SP2 true
#endif
#ifndef PG8_ALIGN
#define PG8_ALIGN true
#endif
namespace pg8 {
struct EpiSwiGLU {
    static constexpr bool PERM = true, AFTER_DRAIN = false;
    bf16_t* O; int ldc;
    __device__ __forceinline__ void operator()(const f32x4 (&acc)[2][2][4][2], const Unit& u, int wr, int wc, int fr, int fq) const {
        const int row0 = u.pm * BM + wr * 64 + fr, col0 = u.pn * HALF + wc * 32 + 8 * fq;
#pragma unroll
        for (int ai = 0; ai < 2; ++ai)
#pragma unroll
            for (int m = 0; m < 4; ++m) { bf16_t* rowp = O + (size_t)(row0 + ai * HALF + m * 16) * ldc + col0;
                f32x4 h[2];
#pragma unroll
                for (int n = 0; n < 2; ++n) { const f32x4 g = acc[ai][0][m][n], up = acc[ai][1][m][n];
#pragma unroll
                    for (int e = 0; e < 4; ++e) { const float ex = __builtin_amdgcn_exp2f(g[e] * (-1.4426950408889634f)); h[n][e] = g[e] * up[e] * __builtin_amdgcn_rcpf(1.0f + ex); } }
                u32x4 w; w.x = cvt_pk_bf16(h[0][0], h[0][1]); w.y = cvt_pk_bf16(h[0][2], h[0][3]); w.z = cvt_pk_bf16(h[1][0], h[1][1]); w.w = cvt_pk_bf16(h[1][2], h[1][3]);
                *(u32x4*)rowp = w; }
    }
};
struct EpiLnAff {
    static constexpr bool PERM = true, AFTER_DRAIN = true;
    const float* base; const bf16_t* basebf; float* out; bf16_t* xn; int ldc; const float* gam; const float* bet; float alpha; PanelStats st; unsigned poison;
    __device__ __forceinline__ void fused(f32x4 (&acc)[2][2][4][2], const Unit& u, int wr, int wc, int fr, int fq, PG8_LAS unsigned char* lds, int wid, int lane) const {
        typedef float f32x2v __attribute__((ext_vector_type(2)));
        const PG8_LAS f32x2v* S = (const PG8_LAS f32x2v*)(lds + 8192);
        const int col0 = u.pn * BM + wc * 32 + 8 * fq;
#pragma unroll
        for (int ai = 0; ai < 2; ++ai)
#pragma unroll
            for (int m = 0; m < 4; ++m) { const size_t off = (size_t)(u.pm * BM + ai * HALF + wr * 64 + m * 16 + fr) * ldc + col0;
#pragma unroll
                for (int bj = 0; bj < 2; ++bj) { f32x4 b0, b1;
                    if (basebf) { const u32x4 w = *(const u32x4*)(basebf + off + bj * HALF);
                        b0[0] = __builtin_bit_cast(float, w.x << 16); b0[1] = __builtin_bit_cast(float, w.x & 0xffff0000u); b0[2] = __builtin_bit_cast(float, w.y << 16); b0[3] = __builtin_bit_cast(float, w.y & 0xffff0000u);
                        b1[0] = __builtin_bit_cast(float, w.z << 16); b1[1] = __builtin_bit_cast(float, w.z & 0xffff0000u); b1[2] = __builtin_bit_cast(float, w.w << 16); b1[3] = __builtin_bit_cast(float, w.w & 0xffff0000u); }
                    else { b0 = *(const f32x4*)(base + off + bj * HALF); b1 = *(const f32x4*)(base + off + bj * HALF + 4); }
                    acc[ai][bj][m][0] = b0 * alpha + acc[ai][bj][m][0]; acc[ai][bj][m][1] = b1 * alpha + acc[ai][bj][m][1]; }
                asm volatile("" : "+v"(acc[ai][0][m][0]), "+v"(acc[ai][0][m][1]), "+v"(acc[ai][1][m][0]), "+v"(acc[ai][1][m][1]));
                if (basebf ? (m == 3) : (m & 1)) asm volatile("" ::: "memory"); }
        const bool bad = st.run(acc, u, wr, wc, fr, fq, lds, wid, lane) || poison != 0u;
        const float qnan = __builtin_nanf("");
        f32x4 gv[2][2], bv[2][2];
#pragma unroll
        for (int bj = 0; bj < 2; ++bj)
#pragma unroll
            for (int n = 0; n < 2; ++n) { gv[bj][n] = *(const f32x4*)(gam + col0 + bj * HALF + n * 4); bv[bj][n] = *(const f32x4*)(bet + col0 + bj * HALF + n * 4); }
#pragma unroll
        for (int ai = 0; ai < 2; ++ai)
#pragma unroll
            for (int m = 0; m < 4; ++m) { const int r = ai * HALF + wr * 64 + m * 16 + fr; const f32x2v sr = S[r]; const size_t off = (size_t)(u.pm * BM + r) * ldc + col0;
#pragma unroll
                for (int bj = 0; bj < 2; ++bj) { f32x4 o0 = (acc[ai][bj][m][0] - sr.x) * sr.y * gv[bj][0] + bv[bj][0], o1 = (acc[ai][bj][m][1] - sr.x) * sr.y * gv[bj][1] + bv[bj][1];
                    if (bad) { o0 = (f32x4){qnan, qnan, qnan, qnan}; o1 = o0; }
                    if (out) { __builtin_nontemporal_store(o0, (f32x4*)(out + off + bj * HALF)); __builtin_nontemporal_store(o1, (f32x4*)(out + off + bj * HALF + 4)); }
                    if (xn) { u32x4 w; w.x = cvt_pk_bf16(o0[0], o0[1]); w.y = cvt_pk_bf16(o0[2], o0[3]); w.z = cvt_pk_bf16(o1[0], o1[1]); w.w = cvt_pk_bf16(o1[2], o1[3]); *(u32x4*)(xn + off + bj * HALF) = w; } }
                asm volatile("" ::: "memory"); }
    }
};
}
#include <hip/hip_bf16.h>
#include <cmath>
namespace attn_body {
using bf16=__hip_bfloat16;
using bf16x8=__attribute__((ext_vector_type(8)))short;
using s16x4=__attribute__((ext_vector_type(4)))short;
using f32x16=__attribute__((ext_vector_type(16)))float;
using u32x4=__attribute__((ext_vector_type(4)))unsigned;
using f32x4_t=__attribute__((ext_vector_type(4)))float;
constexpr int BATCH=4,NHEAD=8,SEQ=8192,D=64,DM=1024;
constexpr int NW=8,QBLK=32,QB=QBLK*NW,KVBLK=64,NQB=SEQ/QB;
constexpr int ATTN_PITCH=DM, ATTN_UNIT_ROWS=QB;
__device__ __forceinline__ int crow(int r,int hi){return (r&3)+8*(r>>2)+4*hi;}
#define SBAR() __builtin_amdgcn_sched_barrier(0)
__device__ __forceinline__ void cmask(f32x16&p0,f32x16&p1,int jb,int qrel,int hi){
  const float NEG=-INFINITY; int kb=64*jb+4*hi;
  #pragma unroll
  for(int r=0;r<16;++r){int kv=kb+(r&3)+8*(r>>2); if(kv>qrel)p0[r]=NEG; if(kv+32>qrel)p1[r]=NEG;}
}

constexpr int NSLOT=3, SLOTB=8192;
constexpr int LDS_K=0, LDS_V=NSLOT*SLOTB, LDS_WS=2*NSLOT*SLOTB, LDS_OST=LDS_WS+NW*64*4, LDS_CK=LDS_OST+NW*4096, LDS_BYTES=LDS_CK+SEQ*4;
constexpr float C2=0.125f*1.4426950408889634f;
__device__ __forceinline__ void glds16(const void*gsrc,unsigned lds_dst){unsigned keep;
  asm volatile("s_mov_b32 %0, m0\n\ts_mov_b32 m0, %2\n\ts_nop 0\n\tglobal_load_lds_dwordx4 %1, off\n\ts_mov_b32 m0, %0":"=&s"(keep):"v"(gsrc),"s"(lds_dst):"memory");}
__device__ __forceinline__ float max3f(float a,float b,float c){float r;asm("v_max3_f32 %0, %1, %2, %3":"=v"(r):"v"(a),"v"(b),"v"(c));return r;}
__device__ __forceinline__ float max2f(float a,float b){float r;asm("v_max_f32_e32 %0, %1, %2":"=v"(r):"v"(a),"v"(b));return r;}
__device__ __forceinline__ float fadd_s(float a,float b){float r;asm("v_add_f32_e32 %0, %1, %2":"=v"(r):"v"(a),"v"(b));return r;}
__device__ __forceinline__ float fsub_s(float a,float b){float r;asm("v_sub_f32_e32 %0, %1, %2":"=v"(r):"v"(a),"v"(b));return r;}
typedef float f32x2_t __attribute__((ext_vector_type(2))); typedef __bf16 bf16x2_t __attribute__((ext_vector_type(2)));
__device__ __forceinline__ unsigned cvtpk_s(float lo,float hi){f32x2_t v={lo,hi};bf16x2_t b=__builtin_convertvector(v,bf16x2_t);return __builtin_bit_cast(unsigned,b);}
#define WAIT_BAR(N) asm volatile("s_waitcnt vmcnt(" #N ") lgkmcnt(0)\n\ts_barrier":::"memory")

__device__ __forceinline__ void qkt(f32x16&p0,f32x16&p1,const char*Kslot,const bf16x8*qr,int r32,int hi){
  const char*kb=Kslot+hi*1024+r32*16;
  #pragma unroll
  for(int d0=0;d0<4;++d0){
    const bf16x8 b0=*reinterpret_cast<const bf16x8*>(kb+d0*2048);
    const bf16x8 b1=*reinterpret_cast<const bf16x8*>(kb+d0*2048+512);
    p0=__builtin_amdgcn_mfma_f32_32x32x16_bf16(b0,qr[d0],p0,0,0,0);p1=__builtin_amdgcn_mfma_f32_32x32x16_bf16(b1,qr[d0],p1,0,0,0);}
}
typedef __attribute__((address_space(3))) const char* lds_cptr;
typedef short v4i16_t __attribute__((ext_vector_type(4)));
__device__ __forceinline__ void kload8(bf16x8*kf,lds_cptr kp){
  kf[0]=*(const __attribute__((address_space(3))) bf16x8*)(kp);      kf[1]=*(const __attribute__((address_space(3))) bf16x8*)(kp+512);
  kf[2]=*(const __attribute__((address_space(3))) bf16x8*)(kp+2048); kf[3]=*(const __attribute__((address_space(3))) bf16x8*)(kp+2560);
  kf[4]=*(const __attribute__((address_space(3))) bf16x8*)(kp+4096); kf[5]=*(const __attribute__((address_space(3))) bf16x8*)(kp+4608);
  kf[6]=*(const __attribute__((address_space(3))) bf16x8*)(kp+6144); kf[7]=*(const __attribute__((address_space(3))) bf16x8*)(kp+6656);
}
__device__ __forceinline__ void kload2(bf16x8*kf,lds_cptr kp,int j){ kf[2*j]=*(const __attribute__((address_space(3))) bf16x8*)(kp+j*2048); kf[2*j+1]=*(const __attribute__((address_space(3))) bf16x8*)(kp+j*2048+512); }
__device__ __forceinline__ s16x4 vtr(lds_cptr p){ return __builtin_bit_cast(s16x4,__builtin_amdgcn_ds_read_tr16_b64_v4i16((__attribute__((address_space(3))) v4i16_t*)p)); }
__device__ __forceinline__ float rowmax(const f32x16&p0,const f32x16&p1){
  float a=max3f(p0[0],p0[1],p1[0]),b=max3f(p0[2],p0[3],p1[1]);a=max3f(a,p1[2],p1[3]);
  #pragma unroll
  for(int r=4;r<16;r+=4){a=max3f(a,p0[r],p0[r+1]);b=max3f(b,p0[r+2],p0[r+3]);a=max3f(a,p1[r],p1[r+1]);b=max3f(b,p1[r+2],p1[r+3]);}
  const float m=max2f(a,b);
  auto rr=__builtin_amdgcn_permlane32_swap(__float_as_uint(m),__float_as_uint(m),false,false);
  return max2f(__uint_as_float(rr[0]),__uint_as_float(rr[1]));
}
__device__ __forceinline__ void pv(f32x16*o,int vb,bf16x8 pa0,bf16x8 pa1,bf16x8 pa2,bf16x8 pa3){
  #pragma unroll
  for(int d0=0;d0<2;++d0){s16x4 lo[4],hi[4];
    #pragma unroll
    for(int ks=0;ks<4;++ks){
      asm volatile("ds_read_b64_tr_b16 %0,%1 offset:%c2":"=&v"(lo[ks]):"v"(vb),"i"(d0*4096+ks*1024):"memory");
      asm volatile("ds_read_b64_tr_b16 %0,%1 offset:%c2":"=&v"(hi[ks]):"v"(vb),"i"(d0*4096+ks*1024+512):"memory");}
    asm volatile("s_waitcnt lgkmcnt(0)":::"memory");SBAR();
    #define PK(k) (bf16x8){lo[k][0],lo[k][1],lo[k][2],lo[k][3],hi[k][0],hi[k][1],hi[k][2],hi[k][3]}
    o[d0]=__builtin_amdgcn_mfma_f32_32x32x16_bf16(pa0,PK(0),o[d0],0,0,0);
    o[d0]=__builtin_amdgcn_mfma_f32_32x32x16_bf16(pa1,PK(1),o[d0],0,0,0);
    o[d0]=__builtin_amdgcn_mfma_f32_32x32x16_bf16(pa2,PK(2),o[d0],0,0,0);
    o[d0]=__builtin_amdgcn_mfma_f32_32x32x16_bf16(pa3,PK(3),o[d0],0,0,0);
    #undef PK
  }
}

__device__ __forceinline__ unsigned pack_hilo(float v){ const unsigned hb=cvtpk_s(v,0.f)&0xffffu; const float lo=v-__uint_as_float(hb<<16); return hb|(cvtpk_s(lo,0.f)<<16); }
__device__ __forceinline__ float unpack_hilo(unsigned w){ return __uint_as_float(w<<16)+__uint_as_float(w&0xffff0000u); }
typedef __attribute__((address_space(3))) const f32x4_t* lds_f4ptr;
__device__ __forceinline__ void ldbias_raw(f32x16&c0,f32x16&c1,lds_cptr ckp){
  #pragma unroll
  for(int g=0;g<4;++g){ const f32x4_t a=*(lds_f4ptr)(ckp+g*32), b=*(lds_f4ptr)(ckp+128+g*32);
    c0[4*g]=a[0];c0[4*g+1]=a[1];c0[4*g+2]=a[2];c0[4*g+3]=a[3]; c1[4*g]=b[0];c1[4*g+1]=b[1];c1[4*g+2]=b[2];c1[4*g+3]=b[3]; }
}
__device__ __forceinline__ void ldbias_fin(f32x16&c0,f32x16&c1,float cqm){
  #pragma unroll
  for(int r=0;r<16;++r){ c0[r]=cqm-c0[r]; c1[r]=cqm-c1[r]; }
}
#ifndef ATTN_STORE16
#define ATTN_STORE16(p,v) (*(u32x4*)(p)=(v))
#endif
template<int THRL> __device__ __forceinline__ void attn_unit(int b,int h,int qb,const bf16*Q,const bf16*__restrict__ K,const bf16*__restrict__ V,bf16*O,const float*__restrict__ CS,float skipthr,char*shm,int wave_,unsigned*qctr,unsigned&nxt_,bool lead_){
  const int wid=__builtin_amdgcn_readfirstlane(wave_),lane=mk_lane_id(),tid=wid*64+lane,r32=lane&31,hi=lane>>5;
  const long rowbase=(long)b*SEQ; const int q0=qb*QB;
  const bf16*Qw=Q+(rowbase+q0+wid*QBLK)*DM+h*D;
  const bf16*Kh=K+rowbase*DM+h*D,*Vh=V+rowbase*DM+h*D;
  const unsigned lds0=(unsigned)(uintptr_t)shm;
  float*wsf=(float*)(shm+LDS_WS)+wid*64;
  const bf16*ksrc=Kh+(long)lane*DM+wid*8;
  const bf16*vsrc=Vh+(long)(16*(wid&3)+(lane>>2))*DM+(wid>>2)*32+(lane&3)*8;
  const unsigned kdst=lds0+LDS_K+wid*1024, vdst=lds0+LDS_V+wid*1024;
  #define DMA_K(t,slot) glds16(ksrc+(long)(NT-1-(t))*KVBLK*DM,(unsigned)__builtin_amdgcn_readfirstlane(kdst+(slot)))
  #define DMA_V(t,slot) glds16(vsrc+(long)(NT-1-(t))*KVBLK*DM,(unsigned)__builtin_amdgcn_readfirstlane(vdst+(slot)))
  const int vb0=(int)(lds0+LDS_V)+((lane>>4)&1)*32+(lane&3)*8+(4*hi+((lane&15)>>2))*64;
  const char*Kbase=shm+LDS_K; bf16x8 kf[8];
  const lds_cptr shm3=(lds_cptr)shm; const lds_cptr kp0=shm3+LDS_K+hi*1024+r32*16; const lds_cptr vp0=shm3+LDS_V+((lane>>4)&1)*32+(lane&3)*8+(4*hi+((lane&15)>>2))*64;
  const int NT=(q0+QB)/KVBLK;
  const float*cgl=CS+(long)(b*NHEAD+h)*SEQ; const float cref=cgl[q0];
  f32x4_t cv[4];
  #pragma unroll
  for(int k=0;k<4;++k){ const int idx=tid+512*k; cv[k]=(4*idx<q0+QB)?*reinterpret_cast<const f32x4_t*>(cgl+4*idx):(f32x4_t){0.f,0.f,0.f,0.f}; }
  DMA_K(0,0);DMA_V(0,0);DMA_K(1,SLOTB);
  bf16x8 qr[4];
  #pragma unroll
  for(int d0=0;d0<4;++d0)qr[d0]=*reinterpret_cast<const bf16x8*>(&Qw[(long)r32*DM+d0*16+hi*8]);
  #pragma unroll
  for(int k=0;k<4;++k){ const int idx=tid+512*k; if(4*idx<q0+QB){ const f32x4_t e_=(cref-cv[k])*1.4426950408889634f; *(__attribute__((address_space(3))) u32x4*)(shm3+LDS_CK+16*idx)=(u32x4){pack_hilo(e_[0]),pack_hilo(e_[1]),pack_hilo(e_[2]),pack_hilo(e_[3])}; } }
  const lds_cptr cke=shm3+LDS_CK+4*r32;
  const unsigned qxw=hi?0u:0x3f803f80u; const bf16x8 qext=__builtin_bit_cast(bf16x8,(u32x4){qxw,0u,0u,0u});
  #define KEXT(w) __builtin_bit_cast(bf16x8,(u32x4){(w),0u,0u,0u})
  #define KEW(tile,half) (*(const __attribute__((address_space(3))) unsigned*)(cke+256*(tile)+128*(half)))
  float l_reg=0.f;f32x16 o[2];o[0]=f32x16{};o[1]=f32x16{};
  const int qrel=wid*QBLK+r32;
  #define CMASK(P0,P1,t) do{int jb_=3-(t); if(jb_>=0)cmask(P0,P1,jb_,qrel,hi);}while(0)
  bool resc=false;
  #define START(P0,P1) do{ const float rm=rowmax(P0,P1); resc=false; \
    { const float dl=(rm>-1e30f)?rm:0.f; cqm=fsub_s(cqm,dl);   \
      _Pragma("unroll") for(int r=0;r<16;++r){P0[r]=fsub_s(P0[r],dl);P1[r]=fsub_s(P1[r],dl);} \
      _Pragma("unroll") for(int r=0;r<16;++r)cq16[r]=cqm; asm volatile("":"+v"(cq16)); } \
    _Pragma("unroll") for(int r=0;r<16;++r)P0[r]=__builtin_amdgcn_exp2f(P0[r]); }while(0)
  #define RESC() do{ if(resc){ asm volatile("s_waitcnt lgkmcnt(0)":::"memory"); \
      _Pragma("unroll") for(int d_=0;d_<2;++d_) _Pragma("unroll") for(int r=0;r<16;++r)o[d_][r]*=wsf[crow(r,hi)]; } }while(0)
  f32x16 pA0,pA1,pB0,pB1;
  int sl_prev=0,sl_cur=0,sl_next=SLOTB;
  #define ROT() do{sl_prev=sl_cur;sl_cur=sl_next;sl_next=(sl_next==(NSLOT-1)*SLOTB)?0:sl_next+SLOTB;}while(0)
  DMA_K(2,2*SLOTB);
  WAIT_BAR(3);
  int NS; { int lo_=0,hi_=NT-4; while(lo_<hi_){ const int mid_=(lo_+hi_)>>1; const float cv_=-unpack_hilo(*(const __attribute__((address_space(3))) unsigned*)(shm3+LDS_CK+4*(64*mid_+63))); if(cv_<=skipthr)hi_=mid_; else lo_=mid_+1; }
    NS=__builtin_amdgcn_readfirstlane((NT-lo_+1)&~1); }
  float cqm=-unpack_hilo(*(const __attribute__((address_space(3))) unsigned*)(shm3+LDS_CK+4*(q0+qrel)));
  f32x16 cq16; _Pragma("unroll") for(int r=0;r<16;++r)cq16[r]=cqm; asm volatile("":"+v"(cq16));
  pA0=cq16; pA1=cq16;
  { const unsigned w0_=KEW(NT-1,0),w1_=KEW(NT-1,1); pA0=__builtin_amdgcn_mfma_f32_32x32x16_bf16(KEXT(w0_),qext,pA0,0,0,0); pA1=__builtin_amdgcn_mfma_f32_32x32x16_bf16(KEXT(w1_),qext,pA1,0,0,0); }
  qkt(pA0,pA1,Kbase,qr,r32,hi);asm volatile("s_nop 15\n\ts_nop 7":"+v"(pA0),"+v"(pA1));CMASK(pA0,pA1,0);
  START(pA0,pA1);
  _Pragma("unroll") for(int r=0;r<16;++r)pA1[r]=__builtin_amdgcn_exp2f(pA1[r]);
  WAIT_BAR(0);
  DMA_K(3,0);DMA_V(1,SLOTB);
  ROT();
  kload8(kf,kp0+sl_cur);
  WAIT_BAR(2);
  s16x4 vlo[8],vhi[8]; u32x4 pw0,pw1,pw2,pw3;
  #define PKW(P,B) cvtpk_s(P[B],P[B+1])
  #define PAF(k) __builtin_bit_cast(bf16x8,pw##k)
  #define VFR(i) (bf16x8){vlo[i][0],vlo[i][1],vlo[i][2],vlo[i][3],vhi[i][0],vhi[i][1],vhi[i][2],vhi[i][3]}
  #define PIN(x) asm volatile("":"+v"(x))
  #define MX3(a,b,c) __builtin_fmaxf(__builtin_fmaxf((a),(b)),(c))
  #define GAPA(MF,A0,A1,A2,A3,W0,W1,PW) do{ MF; sacc+=A0; sacc+=A1; sacc+=A2; sacc+=A3; PIN(sacc); W0; W1; PIN(PW); SBAR(); }while(0)
  #define EX(v) __builtin_amdgcn_exp2f(v)
  #define GAPB(MF,X,B) do{ MF; X[B]=EX(X[B]); X[B+1]=EX(X[B+1]); X[B+2]=EX(X[B+2]); X[B+3]=EX(X[B+3]); PIN(X); SBAR(); }while(0)
  #define VRD(i) do{ vlo[i]=vtr(vp_+(((i)>>2)*4096+((i)&3)*1024)); vhi[i]=vtr(vp_+(((i)>>2)*4096+((i)&3)*1024+512)); }while(0)
  #define KRD(G,j) do{ if(G){ kload2(kf,kp0+sl_next,j); SBAR(); } }while(0)
  #define STEP(C0,C1,P0,P1,t,GK,GV,GL) do{ SBAR(); \
    const unsigned kw0_=KEW(NT-1-(t),0),kw1_=KEW(NT-1-(t),1);   \
    const lds_cptr vp_=vp0+sl_prev; \
    VRD(0); SBAR(); float sacc=(P0[0]+P0[1]); \
    GAPA(C0=__builtin_amdgcn_mfma_f32_32x32x16_bf16(kf[0],qr[0],cq16,0,0,0), P0[2],P0[3],P0[4],P0[5],     pw0[0]=PKW(P0,0), pw0[1]=PKW(P0,2), pw0); \
    VRD(4); SBAR(); GAPA(C1=__builtin_amdgcn_mfma_f32_32x32x16_bf16(kf[1],qr[0],cq16,0,0,0), P0[6],P0[7],P0[8],P0[9],     pw0[2]=PKW(P0,4), pw0[3]=PKW(P0,6), pw0); \
    VRD(1); SBAR(); GAPA(C0=__builtin_amdgcn_mfma_f32_32x32x16_bf16(kf[2],qr[1],C0,0,0,0),   P0[10],P0[11],P0[12],P0[13], pw1[0]=PKW(P0,8), pw1[1]=PKW(P0,10), pw1); \
    VRD(5); SBAR(); GAPA(C1=__builtin_amdgcn_mfma_f32_32x32x16_bf16(kf[3],qr[1],C1,0,0,0),   P0[14],P0[15],P1[0],P1[1],   pw1[2]=PKW(P0,12),pw1[3]=PKW(P0,14), pw1); \
    VRD(2); SBAR(); GAPA(C0=__builtin_amdgcn_mfma_f32_32x32x16_bf16(kf[4],qr[2],C0,0,0,0),   P1[2],P1[3],P1[4],P1[5],     pw2[0]=PKW(P1,0), pw2[1]=PKW(P1,2), pw2); \
    VRD(6); SBAR(); GAPA(C1=__builtin_amdgcn_mfma_f32_32x32x16_bf16(kf[5],qr[2],C1,0,0,0),   P1[6],P1[7],P1[8],P1[9],     pw2[2]=PKW(P1,4), pw2[3]=PKW(P1,6), pw2); \
    VRD(3); SBAR(); GAPA(C0=__builtin_amdgcn_mfma_f32_32x32x16_bf16(kf[6],qr[3],C0,0,0,0),   P1[10],P1[11],P1[12],P1[13], pw3[0]=PKW(P1,8), pw3[1]=PKW(P1,10), pw3); \
    VRD(7); SBAR(); GAPA(C1=__builtin_amdgcn_mfma_f32_32x32x16_bf16(kf[7],qr[3],C1,0,0,0),   P1[14],P1[15],0.f,0.f,       pw3[2]=PKW(P1,12),pw3[3]=PKW(P1,14), pw3); \
    C0=__builtin_amdgcn_mfma_f32_32x32x16_bf16(KEXT(kw0_),qext,C0,0,0,0); C1=__builtin_amdgcn_mfma_f32_32x32x16_bf16(KEXT(kw1_),qext,C1,0,0,0); SBAR(); \
    l_reg+=sacc; \
    if(GK){DMA_K((t)+3,sl_cur);} if(GV){DMA_V((t)+1,sl_next);} \
    CMASK(C0,C1,t); \
    { float a=MX3(C0[0],C0[1],C1[0]),b=MX3(C0[2],C0[3],C1[1]); a=MX3(a,C1[2],C1[3]); \
      _Pragma("unroll") for(int r=4;r<16;r+=4){a=MX3(a,C0[r],C0[r+1]);b=MX3(b,C0[r+2],C0[r+3]);a=MX3(a,C1[r],C1[r+1]);b=MX3(b,C1[r+2],C1[r+3]);} \
      float rm=__builtin_fmaxf(a,b); { auto rr=__builtin_amdgcn_permlane32_swap(__float_as_uint(rm),__float_as_uint(rm),false,false); rm=__builtin_fmaxf(__uint_as_float(rr[0]),__uint_as_float(rr[1])); } \
      resc=false; \
      if(__builtin_expect(__any(rm>(float)THRL),0)){ const float dl=__builtin_fmaxf(rm,0.f); cqm-=dl; \
        _Pragma("unroll") for(int r=0;r<16;++r)cq16[r]=cqm; asm volatile("":"+v"(cq16)); \
        _Pragma("unroll") for(int r=0;r<16;++r){C0[r]-=dl;C1[r]-=dl;} \
        const float f=__builtin_amdgcn_exp2f(-dl); l_reg*=f; if(hi==0)wsf[r32]=f; resc=true; } } \
    SBAR(); \
    GAPB(o[0]=__builtin_amdgcn_mfma_f32_32x32x16_bf16(PAF(0),VFR(0),o[0],0,0,0), C0,0); \
    GAPB(o[1]=__builtin_amdgcn_mfma_f32_32x32x16_bf16(PAF(0),VFR(4),o[1],0,0,0), C0,4); \
    KRD(GL,0); GAPB(o[0]=__builtin_amdgcn_mfma_f32_32x32x16_bf16(PAF(1),VFR(1),o[0],0,0,0), C0,8); \
    KRD(GL,1); GAPB(o[1]=__builtin_amdgcn_mfma_f32_32x32x16_bf16(PAF(1),VFR(5),o[1],0,0,0), C0,12); \
    KRD(GL,2); GAPB(o[0]=__builtin_amdgcn_mfma_f32_32x32x16_bf16(PAF(2),VFR(2),o[0],0,0,0), C1,0); \
    KRD(GL,3); GAPB(o[1]=__builtin_amdgcn_mfma_f32_32x32x16_bf16(PAF(2),VFR(6),o[1],0,0,0), C1,4); \
    GAPB(o[0]=__builtin_amdgcn_mfma_f32_32x32x16_bf16(PAF(3),VFR(3),o[0],0,0,0), C1,8); \
    GAPB(o[1]=__builtin_amdgcn_mfma_f32_32x32x16_bf16(PAF(3),VFR(7),o[1],0,0,0), C1,12); \
    }while(0)
  int t=1;
  for(;t+5<NS;t+=2){
    STEP(pB0,pB1,pA0,pA1,t,true,true,true);     WAIT_BAR(2); RESC(); ROT();
    STEP(pA0,pA1,pB0,pB1,t+1,true,true,true);   WAIT_BAR(2); RESC(); ROT();
  }
  #define ENDW(tt) do{ if((tt)+3<NS){WAIT_BAR(2);} else if((tt)+2<NS){WAIT_BAR(1);} else {WAIT_BAR(0);} }while(0)
  for(;t+1<NS;t+=2){
    STEP(pB0,pB1,pA0,pA1,t,(t+3<NS),(t+1<NS),(t+1<NS));       ENDW(t);   RESC(); ROT();
    STEP(pA0,pA1,pB0,pB1,t+1,(t+4<NS),(t+2<NS),(t+2<NS));     ENDW(t+1); RESC(); ROT();
  }
  STEP(pB0,pB1,pA0,pA1,NS-1,false,false,false); RESC();
  { float sacc=pB0[0]+pB0[1]; _Pragma("unroll") for(int r=2;r<16;++r)sacc+=pB0[r]; _Pragma("unroll") for(int r=0;r<16;++r)sacc+=pB1[r]; l_reg+=sacc;
    pw0=(u32x4){PKW(pB0,0),PKW(pB0,2),PKW(pB0,4),PKW(pB0,6)};pw1=(u32x4){PKW(pB0,8),PKW(pB0,10),PKW(pB0,12),PKW(pB0,14)};pw2=(u32x4){PKW(pB1,0),PKW(pB1,2),PKW(pB1,4),PKW(pB1,6)};pw3=(u32x4){PKW(pB1,8),PKW(pB1,10),PKW(pB1,12),PKW(pB1,14)};
    SBAR(); pv(o,vb0+sl_cur,PAF(0),PAF(1),PAF(2),PAF(3)); }
  #undef PKW
  #undef PAF
  #undef VFR
  #undef PIN
  #undef MX3
  #undef GAPA
  #undef GAPB
  #undef EX
  #undef VRD
  #undef KRD
  #undef STEP
  #undef ENDW
  if(lead_)nxt_=atomicAdd(qctr,1u);
  {auto rr=__builtin_amdgcn_permlane32_swap(__float_as_uint(l_reg),__float_as_uint(l_reg),false,false);l_reg=__uint_as_float(rr[0])+__uint_as_float(rr[1]);}
  if(hi==0)wsf[32+r32]=l_reg;asm volatile("s_waitcnt lgkmcnt(0)":::"memory");
  float rli[16];
  #pragma unroll
  for(int r=0;r<16;++r)rli[r]=__builtin_amdgcn_rcpf(wsf[32+crow(r,hi)]);
  bf16*Ow=O+(rowbase+q0+wid*QBLK)*DM+h*D;
  { bf16*stg=(bf16*)(shm+LDS_OST)+wid*2048;
    #pragma unroll
    for(int r=0;r<16;++r){const int orow=crow(r,hi);
      #pragma unroll
      for(int d0=0;d0<2;++d0)stg[orow*64+d0*32+r32]=__float2bfloat16(o[d0][r]*rli[r]);}
    asm volatile("s_waitcnt lgkmcnt(0)":::"memory");
    #pragma unroll
    for(int i=0;i<4;++i){const int row=i*8+(lane>>3),ch=lane&7; const u32x4 v=*(const u32x4*)(stg+row*64+ch*8); ATTN_STORE16(Ow+(long)row*DM+ch*8,v);} }
  asm volatile("s_waitcnt lgkmcnt(0)\n\ts_barrier":::"memory");
  #undef DMA_K
  #undef DMA_V
  #undef CMASK
  #undef START
  #undef RESC
  #undef ROT
}
constexpr int ATTN_LDS_BYTES=LDS_BYTES;
struct AttnTensors { const bf16* Q; const bf16* K; const bf16* V; bf16* O; const float* CS; const unsigned* nrm; unsigned* qctr; };
template<int THRL=8> __device__ __forceinline__ void attn_phase(char*lds,const AttnTensors&T,volatile __attribute__((address_space(3))) unsigned*qw,int wave_){
  const bool lead_=(wave_==0&&mk_lane_id()==0); unsigned nxt_=0u; if(lead_)nxt_=atomicAdd(T.qctr,1u);
  for(;;){
    if(lead_){ *qw=nxt_; }
    asm volatile("s_waitcnt vmcnt(0) lgkmcnt(0)\n\ts_barrier":::"memory");
    const unsigned u=__builtin_amdgcn_readfirstlane(*qw);
    if(u>=(unsigned)(BATCH*NHEAD*NQB))break;
    const int bh=(int)(u&31u),qb=NQB-1-(int)(u>>5);
    const float qp=__uint_as_float(__hip_atomic_load(T.nrm+bh,__ATOMIC_RELAXED,__HIP_MEMORY_SCOPE_AGENT)),kp=__uint_as_float(__hip_atomic_load(T.nrm+32+bh,__ATOMIC_RELAXED,__HIP_MEMORY_SCOPE_AGENT));
    const float skipthr=160.f+4.1f*sqrtf(qp*kp);
    attn_unit<THRL>(bh/NHEAD,bh%NHEAD,qb,T.Q,T.K,T.V,T.O,T.CS,skipthr,lds,wave_,T.qctr,nxt_,lead_);
  }
}
#undef SBAR
#undef WAIT_BAR
}

#include <hip/hip_cooperative_groups.h>
namespace cg = cooperative_groups;
constexpr int NWAVES = 8;
#ifndef MK_N_LAUNCHES
#define MK_N_LAUNCHES 1
#endif
constexpr int NPH = 11;
constexpr int N_LAUNCHES = MK_N_LAUNCHES;
static_assert(N_LAUNCHES == 1 || N_LAUNCHES == NPH, "MK_N_LAUNCHES is 1 or 11");

constexpr int BATCH = 4, SEQ = 8192, D = 1024, M = BATCH * SEQ, NH = 8;
constexpr int EVEN_IN = 3080, NIN0 = 3072, FFH = 2816, NFF = 2 * FFH, NG = 2048;
constexpr float LN_EPS = 1e-5f, ALPHA = 1.4142135623730951f;

constexpr size_t MiB = 1u << 20;
constexpr size_t WS_CTL = 0, CTL_ZERO_BYTES = 1 * MiB;
constexpr size_t WS_X = 1 * MiB;
constexpr size_t WS_CSUM = 5 * MiB, WS_LOGF = 6 * MiB, WS_RSW = 7 * MiB;
constexpr size_t WS_WIN0 = 8 * MiB, WS_WOUT0 = 14 * MiB, WS_WFI0 = 16 * MiB, WS_WFO0 = 27 * MiB, WS_WIN1 = 33 * MiB, WS_WOUT1 = 37 * MiB, WS_WFI1 = 39 * MiB, WS_WFO1 = 50 * MiB;
constexpr size_t WS_XN = 56 * MiB, WS_MIX = 120 * MiB, WS_BIG = 184 * MiB, WS_PART = 376 * MiB, WS_END = 378 * MiB;
constexpr size_t BUF = (size_t)M * D;
constexpr int CW_NRM = 64, CW_QCTR = 192;
constexpr int CW_TMO = 0, CW_CODE = 1, CW_SEAM = 16384, SEAM_BANK = 128 * 64;
static_assert((CW_SEAM + 4 * SEAM_BANK) * 4 <= (int)CTL_ZERO_BYTES, "CTL words inside the memset region");

constexpr int RING_BYTES = 131072, LDS_BYTES = 147456, MISC_OFF = LDS_BYTES - 256;
static_assert(attn_body::ATTN_LDS_BYTES <= RING_BYTES, "attention scratch fits the ring region");

#define LAS __attribute__((address_space(3)))
typedef unsigned short bf16;
typedef unsigned v4u __attribute__((ext_vector_type(4)));
typedef unsigned v2u __attribute__((ext_vector_type(2)));
typedef float f32x4 __attribute__((ext_vector_type(4)));
typedef short bf16x8 __attribute__((ext_vector_type(8)));
typedef float f32x16 __attribute__((ext_vector_type(16)));
#define RLX_AGENT __ATOMIC_RELAXED, __HIP_MEMORY_SCOPE_AGENT
#define LDS_WAIT() asm volatile("s_waitcnt lgkmcnt(0)" ::: "memory")
__device__ __forceinline__ unsigned f2bf(float f) { unsigned u = __builtin_bit_cast(unsigned, f); return (u + 0x7fffu + ((u >> 16) & 1u)) >> 16; }
__device__ __forceinline__ unsigned pk2(float lo, float hi) { return f2bf(lo) | (f2bf(hi) << 16); }
__device__ __forceinline__ float bf2f(unsigned short h) { return __builtin_bit_cast(float, (unsigned)h << 16); }
__device__ __forceinline__ float bflo(unsigned w) { return __builtin_bit_cast(float, w << 16); }
__device__ __forceinline__ float bfhi(unsigned w) { return __builtin_bit_cast(float, w & 0xffff0000u); }

#define XB_TMO      128
#define XB_XCNT(j)  (256  + 64 * (j))
#define XB_XSUB(j)  (1280 + 64 * (j))
#define XB_XGEN(j)  (2304 + 64 * (j))
#define XB_TOP      3328
#define XB_TOPGEN   3392
#define XCD_BAR_WORDS 3456
#define XB_SPIN_CAP (1u << 18)

__device__ __forceinline__ unsigned xb_ld(unsigned* p)              { return __hip_atomic_load(p, __ATOMIC_RELAXED, __HIP_MEMORY_SCOPE_AGENT); }
__device__ __forceinline__ unsigned xb_add(unsigned* p, unsigned v) { return __hip_atomic_fetch_add(p, v, __ATOMIC_RELAXED, __HIP_MEMORY_SCOPE_AGENT); }
__device__ __forceinline__ unsigned xb_xcc_id() { return (unsigned)__builtin_amdgcn_s_getreg((3 << 11) | 20) & 0xFu; }
#define XB_SPIN(cond, bar) do { unsigned _sp = 0; while (cond) { __builtin_amdgcn_s_sleep(1); \
    if ((++_sp & 255u) == 0u) { if (xb_ld(&(bar)[XB_TMO])) break; if (_sp > XB_SPIN_CAP) { atomicAdd(&(bar)[XB_TMO], 1u); break; } } } } while (0)

struct XcdBarrier {
    unsigned* bar; unsigned x;
    volatile LAS unsigned* st;
};

__device__ __forceinline__ XcdBarrier xcd_barrier_post(unsigned* bar, volatile LAS unsigned* st) {
    XcdBarrier b; b.bar = bar; b.x = xb_xcc_id(); b.st = st;
    if (threadIdx.x == 0) (void)xb_add(&bar[XB_XCNT(b.x)], 1u);
    return b;
}
__device__ __forceinline__ void xcd_barrier_complete(unsigned* bar, unsigned x, unsigned& nloc, unsigned& nx) {
    const unsigned G = gridDim.x * gridDim.y * gridDim.z;
    unsigned sum, cnt, mine, sp = 0u;
    for (;;) {
        sum = 0u; cnt = 0u; mine = 0u;
#pragma unroll
        for (unsigned j = 0; j < 16; ++j) { const unsigned c = xb_ld(&bar[XB_XCNT(j)]); sum += c; cnt += (c > 0u) ? 1u : 0u; mine = (j == x) ? c : mine; }
        if (sum == G) break;
        __builtin_amdgcn_s_sleep(1);
        if ((++sp & 255u) == 0u) { if (xb_ld(&bar[XB_TMO])) break; if (sp > XB_SPIN_CAP) { atomicAdd(&bar[XB_TMO], 1u); break; } }
    }
    nloc = mine > 0u ? mine : 1u; nx = cnt > 0u ? cnt : 1u;
}

__device__ __forceinline__ void xcd_barrier(const XcdBarrier& b) {
    asm volatile("s_waitcnt vmcnt(0)" ::: "memory");
    __syncthreads();
    if (threadIdx.x == 0) {
        unsigned* bar = b.bar;
        __builtin_amdgcn_s_waitcnt(0);
        unsigned nloc = b.st[0], nx = b.st[1];
        if (nloc == 0u) { xcd_barrier_complete(bar, b.x, nloc, nx); b.st[0] = nloc; b.st[1] = nx; }
        const unsigned old = xb_add(&bar[XB_XSUB(b.x)], 1u);
        const unsigned gen = old / nloc;
        if (old + 1u == (gen + 1u) * nloc) {
            __builtin_amdgcn_fence(__ATOMIC_RELEASE, "agent");
            asm volatile("s_waitcnt vmcnt(0)" ::: "memory");
            const unsigned og = xb_add(&bar[XB_TOP], 1u);
            const unsigned tg = og / nx;
            if (og + 1u == (tg + 1u) * nx) xb_add(&bar[XB_TOPGEN], 1u);
            else XB_SPIN(xb_ld(&bar[XB_TOPGEN]) == tg, bar);
            __builtin_amdgcn_fence(__ATOMIC_ACQUIRE, "agent");
            xb_add(&bar[XB_XGEN(b.x)], 1u);
            asm volatile("s_waitcnt vmcnt(0)" ::: "memory");
        } else {
            XB_SPIN(xb_ld(&bar[XB_XGEN(b.x)]) == gen, bar);
            __builtin_amdgcn_fence(__ATOMIC_ACQUIRE, "agent");
            asm volatile("s_waitcnt vmcnt(0)" ::: "memory");
        }
    }
    __syncthreads();
}
constexpr int CW_BAR = 4096;
static_assert(CW_BAR + XCD_BAR_WORDS <= 16384, "barrier words below the panel counters");

struct Frame {
    LAS unsigned char* lds; unsigned char* ldsg;
    unsigned* ctl; unsigned char* ws;
    int wave, vcu, G;
};
struct Args { const float* in[17]; float* out; unsigned char* ws; int ph_lo, ph_hi; };
typedef const __attribute__((address_space(4))) Args* kargs_ptr;
__device__ __forceinline__ kargs_ptr kargs() {
#if defined(__HIP_DEVICE_COMPILE__)
    unsigned long long p = (unsigned long long)__builtin_amdgcn_kernarg_segment_ptr(); asm volatile("" : "+s"(p)); return (kargs_ptr)p;
#else
    return nullptr;
#endif
}

__device__ __forceinline__ float wave_sum(float v) {
#pragma unroll
    for (int o = 1; o < 64; o <<= 1) v += __shfl_xor(v, o);
    return v;
}
__device__ __forceinline__ void tr_item(const float* W, int K, int ldw, int srccol0, bf16* WT, int dstrow0, int k0, float scale, LAS float* scr, int lane) {
#pragma unroll 8
    for (int i = 0; i < 32; ++i) { const int kk = 2 * i + (lane >> 5); scr[kk * 33 + (lane & 31)] = W[(size_t)(k0 + kk) * ldw + srccol0 + (lane & 31)] * scale; }
    LDS_WAIT(); asm volatile("" ::: "memory");
    const int c = lane & 7;
#pragma unroll
    for (int j = 0; j < 4; ++j) { const int n = (lane >> 3) + 8 * j; const LAS float* sp = scr + (8 * c) * 33 + n;
        v4u o; o.x = pk2(sp[0 * 33], sp[1 * 33]); o.y = pk2(sp[2 * 33], sp[3 * 33]); o.z = pk2(sp[4 * 33], sp[5 * 33]); o.w = pk2(sp[6 * 33], sp[7 * 33]);
        *(v4u*)(WT + (size_t)(dstrow0 + n) * K + k0 + 8 * c) = o; }
    LDS_WAIT(); asm volatile("" ::: "memory");
}

__device__ __forceinline__ void p0_prologue(Frame& F) {
    LAS float* scr = (LAS float*)(F.lds + F.wave * 16384);
    kargs_ptr KA = kargs(); const int gw = F.vcu * NWAVES + F.wave, NGW = F.G * NWAVES, lane = mk_lane_id();
    constexpr int I_IN0 = 16 * 96, I_OUT = 16 * 32, I_FI = 16 * 176, I_FO = 44 * 32, I_IN1 = 16 * 64;
    constexpr int NITEMS = I_IN0 + 2 * I_OUT + 2 * I_FI + 2 * I_FO + I_IN1;
    unsigned char* ws = F.ws;
    for (int it = gw; it < NITEMS; it += NGW) {
        int r = it;
        if (r < I_IN0) { const int kb = r / 96, n0 = 32 * (r % 96); tr_item(KA->in[1], D, EVEN_IN, n0 < 1536 ? n0 : n0 + 8, (bf16*)(ws + WS_WIN0), n0, 64 * kb, n0 < 512 ? attn_body::C2 : 1.0f, scr, lane); continue; } r -= I_IN0;
        if (r < I_OUT) { const int kb = r / 32, n0 = 32 * (r % 32); tr_item(KA->in[4], D, D, n0, (bf16*)(ws + WS_WOUT0), n0, 64 * kb, 1.0f, scr, lane); continue; } r -= I_OUT;
        if (r < I_OUT) { const int kb = r / 32, n0 = 32 * (r % 32); tr_item(KA->in[10], D, D, n0, (bf16*)(ws + WS_WOUT1), n0, 64 * kb, 1.0f, scr, lane); continue; } r -= I_OUT;
        if (r < 2 * I_FI) { const int l = r / I_FI; r -= l * I_FI; const int kb = r / 176, n0 = 32 * (r % 176); const int src = FFH * ((n0 >> 7) & 1) + 128 * (n0 >> 8) + (n0 & 127);
            tr_item(KA->in[13] + (size_t)l * D * NFF, D, NFF, src, (bf16*)(ws + (l ? WS_WFI1 : WS_WFI0)), n0, 64 * kb, 1.0f, scr, lane); continue; } r -= 2 * I_FI;
        if (r < 2 * I_FO) { const int l = r / I_FO; r -= l * I_FO; const int kb = r / 32, n0 = 32 * (r % 32);
            tr_item(KA->in[14] + (size_t)l * FFH * D, FFH, D, n0, (bf16*)(ws + (l ? WS_WFO1 : WS_WFO0)), n0, 64 * kb, 1.0f, scr, lane); continue; } r -= 2 * I_FO;
        { const int kb = r / 64, n0 = 32 * (r % 64); tr_item(KA->in[5], D, NG, n0, (bf16*)(ws + WS_WIN1), n0, 64 * kb, 1.0f, scr, lane); }
    }
    { v4u* xz = (v4u*)(ws + WS_X); const v4u z4 = (v4u){0u, 0u, 0u, 0u}; for (int i = gw * 64 + lane; i < (int)(4 * MiB / 16); i += NGW * 64) xz[i] = z4; }
    if (gw < 1024) { const float* wr = KA->in[8] + (size_t)gw * 128; const int i = gw & 127; float v = wr[lane] + (i >= 64 ? wr[64 + lane] : 0.f); v = wave_sum(v); if (lane == 0) ((float*)(ws + WS_RSW))[gw] = v; }
    float wf[16][8];
#pragma unroll
    for (int j = 0; j < 4; ++j)
#pragma unroll
        for (int e = 0; e < 4; ++e) { const float* p = KA->in[1] + (size_t)(4 * lane + 256 * j + e) * EVEN_IN + 1536; const f32x4 a = *(const f32x4*)p, b = *(const f32x4*)(p + 4);
            wf[j * 4 + e][0] = a[0]; wf[j * 4 + e][1] = a[1]; wf[j * 4 + e][2] = a[2]; wf[j * 4 + e][3] = a[3]; wf[j * 4 + e][4] = b[0]; wf[j * 4 + e][5] = b[1]; wf[j * 4 + e][6] = b[2]; wf[j * 4 + e][7] = b[3]; }
    const float bfl = KA->in[2][lane & 7];
    bf16* XN = (bf16*)(ws + WS_XN); float* LOGF = (float*)(ws + WS_LOGF);
    for (int m = gw; m < M; m += NGW) {
        const f32x4* xr = (const f32x4*)(KA->in[0] + (size_t)m * D) + lane;
        f32x4 v[4];
#pragma unroll
        for (int j = 0; j < 4; ++j) v[j] = __builtin_nontemporal_load(xr + 64 * j);
        float a[8];
#pragma unroll
        for (int h = 0; h < 8; ++h) a[h] = 0.f;
#pragma unroll
        for (int j = 0; j < 4; ++j)
#pragma unroll
            for (int e = 0; e < 4; ++e)
#pragma unroll
                for (int h = 0; h < 8; ++h) a[h] += v[j][e] * wf[j * 4 + e][h];
#pragma unroll
        for (int h = 0; h < 8; ++h) a[h] = wave_sum(a[h]);
        unsigned long long* o8 = (unsigned long long*)(XN + (size_t)m * D) + lane;
#pragma unroll
        for (int j = 0; j < 4; ++j) o8[64 * j] = (unsigned long long)pk2(v[j][0], v[j][1]) | ((unsigned long long)pk2(v[j][2], v[j][3]) << 32);
        if (lane < 8) { float z = a[0];
#pragma unroll
            for (int h = 1; h < 8; ++h) z = (lane == h) ? a[h] : z;
            z += bfl;
            const float lf = (z >= 0.f) ? -log1pf(expf(-z)) : z - log1pf(expf(z));
            LOGF[(size_t)((m >> 13) * NH + lane) * SEQ + (m & (SEQ - 1))] = lf; }
    }
}

__device__ __forceinline__ void p1_scan(Frame& F, int bh) {
    const float* lf = (const float*)(F.ws + WS_LOGF) + (size_t)bh * SEQ; float* c = (float*)(F.ws + WS_CSUM) + (size_t)bh * SEQ;
    LAS float* wt = (LAS float*)(F.lds + MISC_OFF + 64); const int lane = mk_lane_id(), tid = F.wave * 64 + lane;
    f32x4 v[4]; float run = 0.f;
#pragma unroll
    for (int j = 0; j < 4; ++j) { v[j] = *(const f32x4*)(lf + 16 * tid + 4 * j);
#pragma unroll
        for (int e = 0; e < 4; ++e) { run += v[j][e]; v[j][e] = run; } }
    float inc = run;
#pragma unroll
    for (int o = 1; o < 64; o <<= 1) { const float t = __shfl_up(inc, o); if (lane >= o) inc += t; }
    if (lane == 63) wt[F.wave] = inc;
    __syncthreads();
    float off = inc - run;
    for (int w = 0; w < F.wave; ++w) off += wt[w];
#pragma unroll
    for (int j = 0; j < 4; ++j) *(f32x4*)(c + 16 * tid + 4 * j) = v[j] + off;
    __syncthreads();
}

__device__ __forceinline__ void p2_conv(Frame& F) {
    const bf16* VB = (const bf16*)(F.ws + WS_BIG) + BUF; const bf16* CH = (const bf16*)(F.ws + WS_BIG) + 2 * BUF; bf16* MIX = (bf16*)(F.ws + WS_MIX);
    const int lane = mk_lane_id(); const float* cw = kargs()->in[3];
    float w0[8], w1[8], w2[8];
#pragma unroll
    for (int e = 0; e < 8; ++e) { w0[e] = cw[8 * lane + e]; w1[e] = cw[512 + 8 * lane + e]; w2[e] = cw[1024 + 8 * lane + e]; }
    for (int rb = F.vcu * NWAVES + F.wave; rb < M / 16; rb += F.G * NWAVES) {
        const int t0 = rb * 16; float z1[8], z2[8];
#pragma unroll
        for (int e = 0; e < 8; ++e) { z1[e] = 0.f; z2[e] = 0.f; }
        if ((t0 & (SEQ - 1)) != 0) {
            const v4u c1 = *(const v4u*)(CH + (size_t)(t0 - 1) * D + 8 * lane), h1 = *(const v4u*)(CH + (size_t)(t0 - 1) * D + 512 + 8 * lane);
            const v4u c2 = *(const v4u*)(CH + (size_t)(t0 - 2) * D + 8 * lane), h2 = *(const v4u*)(CH + (size_t)(t0 - 2) * D + 512 + 8 * lane);
#pragma unroll
            for (int e = 0; e < 4; ++e) { z1[2 * e] = bflo(c1[e]) * bflo(h1[e]); z1[2 * e + 1] = bfhi(c1[e]) * bfhi(h1[e]); z2[2 * e] = bflo(c2[e]) * bflo(h2[e]); z2[2 * e + 1] = bfhi(c2[e]) * bfhi(h2[e]); }
        }
#pragma unroll 8
        for (int r = 0; r < 16; ++r) { const size_t t = (size_t)(t0 + r);
            const v4u cg_ = *(const v4u*)(CH + t * D + 8 * lane), hc = *(const v4u*)(CH + t * D + 512 + 8 * lane), bg = *(const v4u*)(VB + t * D + 512 + 8 * lane);
            float z[8], y[8];
#pragma unroll
            for (int e = 0; e < 4; ++e) { z[2 * e] = bflo(cg_[e]) * bflo(hc[e]); z[2 * e + 1] = bfhi(cg_[e]) * bfhi(hc[e]); }
#pragma unroll
            for (int e = 0; e < 8; ++e) y[e] = w0[e] * z2[e] + w1[e] * z1[e] + w2[e] * z[e];
            v4u o;
#pragma unroll
            for (int e = 0; e < 4; ++e) o[e] = pk2(bflo(bg[e]) * y[2 * e], bfhi(bg[e]) * y[2 * e + 1]);
            *(v4u*)(MIX + t * D + 512 + 8 * lane) = o;
#pragma unroll
            for (int e = 0; e < 8; ++e) { z2[e] = z1[e]; z1[e] = z[e]; } }
    }
}

__device__ __forceinline__ void p7_spatial(Frame& F) {
    const bf16* U = (const bf16*)(F.ws + WS_BIG); const bf16* VT = (const bf16*)(F.ws + WS_BIG) + BUF; bf16* GT = (bf16*)(F.ws + WS_MIX);
    kargs_ptr KA = kargs(); const float* lng = KA->in[6]; const float* lnb = KA->in[7]; const float* wsp = KA->in[8]; const float* bsp = KA->in[9]; const float* rsw = (const float*)(F.ws + WS_RSW);
    LAS unsigned char* Wt = F.lds; LAS unsigned char* Vt = F.lds + 34816;
    LAS float* stat = (LAS float*)(F.lds + 69632);
    LAS float* c1s = (LAS float*)(F.lds + 70656);
    LAS float* stage = (LAS float*)(F.lds + 71680);
    LAS float* red = stage;
    const int lane = mk_lane_id(), wave = F.wave, tid = wave * 64 + lane, li = lane & 31, kh = lane >> 5;
    for (int tb = F.vcu; tb < M / 128; tb += F.G) {
        const size_t tok0 = (size_t)tb * 128;
        if (tid < 128) { const f32x4* pp = (const f32x4*)((const float*)(F.ws + WS_PART) + (tok0 + tid) * 16); float s = 0.f, q = 0.f;
#pragma unroll
            for (int k = 0; k < 4; ++k) { const f32x4 v = pp[k]; s += v[0]; q += v[1]; s += v[2]; q += v[3]; }
            const float mean = s * (1.f / 1024.f), var = fmaxf(q * (1.f / 1024.f) - mean * mean, 0.f);
            stat[tid] = mean; stat[128 + tid] = 1.0f / sqrtf(var + LN_EPS); }
        __syncthreads();
        const int dt = wave & 3, ih = wave >> 2, i0 = 64 * ih, nks = ih ? 8 : 4;
        const int srow = tid >> 2, seg = tid & 3;
        const bool wact = (srow >= 64) || (seg < 2);
        v4u vv[4]; f32x4 wv[8];
#define P7_LOAD(gg) do { const v4u* vsrc_ = (const v4u*)(VT + (size_t)(128 * (gg) + srow) * M + tok0 + 32 * seg); _Pragma("unroll") for (int e = 0; e < 4; ++e) vv[e] = vsrc_[e]; \
            if (wact) { const f32x4* wsrc_ = (const f32x4*)(wsp + (size_t)((gg) * 128 + srow) * 128 + 32 * seg); _Pragma("unroll") for (int e = 0; e < 8; ++e) wv[e] = wsrc_[e]; } } while (0)
        P7_LOAD(0);
        for (int g = 0; g < 8; ++g) {
            v4u uu4[4];
#pragma unroll
            for (int ps = 0; ps < 4; ++ps) uu4[ps] = *(const v4u*)(U + (tok0 + 32 * ps + (tid >> 4)) * D + 128 * g + 8 * (tid & 15));
            const int chf = 128 * g + 8 * (tid & 15);
            const f32x4 gl0 = *(const f32x4*)(lng + chf), gl1 = *(const f32x4*)(lng + chf + 4), bl0 = *(const f32x4*)(lnb + chf), bl1 = *(const f32x4*)(lnb + chf + 4);
            float rsv[4], bsvv[4];
#pragma unroll
            for (int ps = 0; ps < 4; ++ps) { rsv[ps] = rsw[g * 128 + 32 * ps + (tid >> 4)]; bsvv[ps] = bsp[g * 128 + 32 * ps + (tid >> 4)]; }
            { const int row = srow;
              float c1p = 0.f;
              if (wact) {
#pragma unroll
                  for (int e = 0; e < 8; ++e) { const f32x4 rr = *(const LAS f32x4*)(stat + 128 + 32 * seg + 4 * e), mm = *(const LAS f32x4*)(stat + 32 * seg + 4 * e); wv[e] = wv[e] * rr;
                      c1p += (wv[e][0] * mm[0] + wv[e][1] * mm[1]) + (wv[e][2] * mm[2] + wv[e][3] * mm[3]); }
#pragma unroll
                  for (int e = 0; e < 4; ++e) { v4u wq; wq.x = pk2(wv[2 * e][0], wv[2 * e][1]); wq.y = pk2(wv[2 * e][2], wv[2 * e][3]); wq.z = pk2(wv[2 * e + 1][0], wv[2 * e + 1][1]); wq.w = pk2(wv[2 * e + 1][2], wv[2 * e + 1][3]);
                      *(LAS v4u*)(Wt + row * 272 + 64 * seg + 16 * e) = wq; } }
              c1p += __shfl_xor(c1p, 1); c1p += __shfl_xor(c1p, 2);
              if (seg == 0) c1s[row] = c1p;
#pragma unroll
              for (int e = 0; e < 4; ++e) *(LAS v4u*)(Vt + row * 272 + 64 * seg + 16 * e) = vv[e]; }
            asm volatile("s_waitcnt lgkmcnt(0)\n\ts_barrier" ::: "memory");
            if (g < 7) P7_LOAD(g + 1);
            f32x16 acc[2]; acc[0] = f32x16{}; acc[1] = f32x16{}; float c1[2];
            c1[0] = c1s[i0 + li]; c1[1] = c1s[i0 + 32 + li];
#pragma unroll
            for (int ks = 0; ks < 8; ++ks) if (ks < nks) {
                const bf16x8 vf = *(const LAS bf16x8*)(Vt + (32 * dt + li) * 272 + (16 * ks + 8 * kh) * 2);
#pragma unroll
                for (int it = 0; it < 2; ++it) { const bf16x8 wf = *(const LAS bf16x8*)(Wt + (i0 + 32 * it + li) * 272 + (16 * ks + 8 * kh) * 2);
                    acc[it] = __builtin_amdgcn_mfma_f32_32x32x16_bf16(vf, wf, acc[it], 0, 0, 0); }
            }
#pragma unroll
            for (int it = 0; it < 2; ++it) {
                LAS float* sp = stage + (i0 + 32 * it + li) * 132 + 32 * dt + 4 * kh;
#pragma unroll
                for (int rg = 0; rg < 4; ++rg) { f32x4 o; o[0] = acc[it][4 * rg + 0] - c1[it]; o[1] = acc[it][4 * rg + 1] - c1[it]; o[2] = acc[it][4 * rg + 2] - c1[it]; o[3] = acc[it][4 * rg + 3] - c1[it]; *(LAS f32x4*)(sp + 8 * rg) = o; } }
            asm volatile("s_waitcnt lgkmcnt(0)\n\ts_barrier" ::: "memory");
            { const int chk = tid & 15, ch = 128 * g + 8 * chk;
#pragma unroll
              for (int ps = 0; ps < 4; ++ps) { const int row = 32 * ps + (tid >> 4); const size_t tok = tok0 + row; const float rs = rsv[ps], bsv = bsvv[ps];
                  const v4u uu = uu4[ps];
                  const f32x4 a0 = *(const LAS f32x4*)(stage + row * 132 + 8 * chk), a1 = *(const LAS f32x4*)(stage + row * 132 + 8 * chk + 4);
                  const f32x4 s0 = gl0 * a0 + (bl0 * rs + bsv), s1 = gl1 * a1 + (bl1 * rs + bsv);
                  v4u o; o.x = pk2(bflo(uu.x) * s0[0], bfhi(uu.x) * s0[1]); o.y = pk2(bflo(uu.y) * s0[2], bfhi(uu.y) * s0[3]); o.z = pk2(bflo(uu.z) * s1[0], bfhi(uu.z) * s1[1]); o.w = pk2(bflo(uu.w) * s1[2], bfhi(uu.w) * s1[3]);
                  *(v4u*)(GT + tok * D + ch) = o; } }
            asm volatile("s_waitcnt lgkmcnt(0)\n\ts_barrier" ::: "memory");
        }
        __syncthreads();
    }
}

__device__ __forceinline__ void ln_gemm(Frame& F, const bf16* A, const bf16* Wt, int K, const float* base, const bf16* basebf, float* out, bf16* xn, const float* gam, const float* bet, int bank) {
    const unsigned poison = (__hip_atomic_load(F.ctl + CW_TMO, RLX_AGENT) != 0u);
    if (F.G != 256) return;
#pragma unroll 1
    for (int sub = 0; sub < 2; ++sub) {
        const size_t r0 = (size_t)sub * 16384;
        pg8::Gemm g{A + r0 * K, Wt, 16384, D, K}; pg8::StaticOrder S; S.init(16384, D, F.G, (int)blockIdx.x);
        pg8::PanelStats st{(unsigned*)(F.ws + WS_X + (size_t)bank * MiB + (size_t)sub * 524288), F.ctl + CW_SEAM + bank * SEAM_BANK + sub * 4096, F.ctl + CW_TMO, D / 256, LN_EPS, 0x700u + 16u * bank + sub};
        pg8::EpiLnAff E{base ? base + r0 * D : nullptr, basebf ? basebf + r0 * D : nullptr, out ? out + r0 * D : nullptr, xn ? xn + r0 * D : nullptr, D, gam, bet, ALPHA, st, poison};
        pg8::gemm_phase<pg8::EpiLnAff, pg8::StaticOrder, false, PG8_SP2>(F.lds, g, S, E, F.wave);
        __syncthreads();
    }
}

__global__ void __launch_bounds__(NWAVES * 64, 2) trunk_fwd(Args args) {
    extern __shared__ __attribute__((aligned(16))) unsigned char lds[];
    Frame F;
    F.lds = (LAS unsigned char*)lds; F.ldsg = lds;
    F.wave = __builtin_amdgcn_readfirstlane((int)threadIdx.x >> 6);
    F.G = gridDim.x; { const int bx = blockIdx.x; F.vcu = (F.G % 8 == 0) ? (bx % 8) * (F.G / 8) + bx / 8 : bx; }
    F.ws = args.ws; F.ctl = (unsigned*)(args.ws + WS_CTL);
    unsigned char* ws = args.ws;
    bf16* XN = (bf16*)(ws + WS_XN); bf16* MIX = (bf16*)(ws + WS_MIX); bf16* BIG = (bf16*)(ws + WS_BIG);
    const int lo = args.ph_lo, hi = args.ph_hi;
    { volatile LAS unsigned* misc = (volatile LAS unsigned*)(F.lds + MISC_OFF); if (threadIdx.x < 32) misc[threadIdx.x] = 0u; }
    __syncthreads();
    XcdBarrier bar; bar.bar = F.ctl + CW_BAR; bar.x = 0; bar.st = nullptr;
    if (N_LAUNCHES == 1) bar = xcd_barrier_post(F.ctl + CW_BAR, (volatile LAS unsigned*)(F.lds + MISC_OFF) + 8);
#ifndef PHMASK
#define PHMASK 0x7ffu
#endif
#define IN(k) (((PHMASK >> (k)) & 1u) && lo <= (k) && (k) < hi)
#define SEAM(k) do { if (IN(k) && IN((k) + 1)) { if (hi > NPH) cg::this_grid().sync(); else xcd_barrier(bar); } } while (0)

    if (IN(0)) { p0_prologue(F); __syncthreads(); }
    SEAM(0);
    if (IN(1)) {
        if (F.vcu < BATCH * NH) p1_scan(F, F.vcu);
        pg8::Gemm g{XN, (const bf16*)(ws + WS_WIN0), M, NIN0, D}; pg8::StaticOrder S; S.init(M, NIN0, F.G, (int)blockIdx.x);
        pg8::EpiBf16QK E{BIG, D, D, BUF, F.ctl + CW_NRM};
        pg8::gemm_phase<pg8::EpiBf16QK, pg8::StaticOrder, PG8_ALIGN, PG8_SP2>(F.lds, g, S, E, F.wave);
    }
    SEAM(1);
    if (IN(2)) {
        const attn_body::AttnTensors AT{(const attn_body::bf16*)BIG, (const attn_body::bf16*)(BIG + 512), (const attn_body::bf16*)(BIG + BUF), (attn_body::bf16*)MIX, (const float*)(ws + WS_CSUM), F.ctl + CW_NRM, F.ctl + CW_QCTR};
        attn_body::attn_phase<8>((char*)lds, AT, (volatile LAS unsigned*)(F.lds + MISC_OFF) + 16, F.wave);
        p2_conv(F);
    }
    SEAM(2);
    if (IN(3)) { kargs_ptr KA = kargs(); ln_gemm(F, MIX, (const bf16*)(ws + WS_WOUT0), D, nullptr, XN, nullptr, XN, KA->in[11], KA->in[12], 0); }
    SEAM(3);
    if (IN(4)) {
        pg8::Gemm g{XN, (const bf16*)(ws + WS_WFI0), M, NFF, D}; pg8::StaticOrder S; S.init(M, NFF, F.G, (int)blockIdx.x);
        pg8::EpiSwiGLU E{BIG, FFH};
        pg8::gemm_phase<pg8::EpiSwiGLU, pg8::StaticOrder, PG8_ALIGN, PG8_SP2>(F.lds, g, S, E, F.wave);
    }
    SEAM(4);
    if (IN(5)) { kargs_ptr KA = kargs(); ln_gemm(F, BIG, (const bf16*)(ws + WS_WFO0), FFH, nullptr, XN, nullptr, XN, KA->in[15], KA->in[16], 1); }
    SEAM(5);
    if (IN(6)) {
        { pg8::Gemm g{XN, (const bf16*)(ws + WS_WIN1), M, D, D}; pg8::StaticOrder S; S.init(M, D, F.G, (int)blockIdx.x);
          pg8::EpiBf16<1> E{BIG, D, nullptr, 0, 0, 1.0f};
          pg8::gemm_phase<pg8::EpiBf16<1>, pg8::StaticOrder, PG8_ALIGN, PG8_SP2>(F.lds, g, S, E, F.wave); }
        __syncthreads();
        { pg8::Gemm g{(const bf16*)(ws + WS_WIN1) + (size_t)D * D, XN, D, M, D}; pg8::StaticOrder S; S.init(D, M, F.G, (int)blockIdx.x);
          pg8::EpiBf16VT E{BIG + BUF, M, (float*)(ws + WS_PART)};
          pg8::gemm_phase<pg8::EpiBf16VT, pg8::StaticOrder, PG8_ALIGN, PG8_SP2>(F.lds, g, S, E, F.wave); }
    }
    SEAM(6);
    if (IN(7)) p7_spatial(F);
    SEAM(7);
    if (IN(8)) { kargs_ptr KA = kargs(); ln_gemm(F, MIX, (const bf16*)(ws + WS_WOUT1), D, nullptr, XN, nullptr, XN, KA->in[11] + D, KA->in[12] + D, 2); }
    SEAM(8);
    if (IN(9)) {
        pg8::Gemm g{XN, (const bf16*)(ws + WS_WFI1), M, NFF, D}; pg8::StaticOrder S; S.init(M, NFF, F.G, (int)blockIdx.x);
        pg8::EpiSwiGLU E{BIG, FFH};
        pg8::gemm_phase<pg8::EpiSwiGLU, pg8::StaticOrder, PG8_ALIGN, PG8_SP2>(F.lds, g, S, E, F.wave);
    }
    SEAM(9);
    if (IN(10)) { kargs_ptr KA = kargs(); ln_gemm(F, BIG, (const bf16*)(ws + WS_WFO1), FFH, nullptr, XN, KA->out, nullptr, KA->in[15] + D, KA->in[16] + D, 3); }
#undef IN
#undef SEAM
}

extern "C" void kernel_launch(void* const* d_in, const int* in_sizes, int n_in, void* d_out, int out_size, void* d_ws, size_t ws_size, hipStream_t stream) {
    static int grid = 0;
    if (grid == 0) {
        if (n_in != 17 || in_sizes[0] != M * D || out_size != M * D || ws_size < WS_END) { fprintf(stderr, "kernel_launch: unexpected shapes (n_in %d, in0 %d, out %d, ws %zu)\n", n_in, n_in > 0 ? in_sizes[0] : -1, out_size, ws_size); grid = -1; return; }
        int dev = 0, cus = 0, per_cu = 0;
        if (hipGetDevice(&dev) != hipSuccess || hipDeviceGetAttribute(&cus, hipDeviceAttributeMultiprocessorCount, dev) != hipSuccess) { grid = -1; return; }
        if (hipFuncSetAttribute((const void*)trunk_fwd, hipFuncAttributeMaxDynamicSharedMemorySize, LDS_BYTES) != hipSuccess) { fprintf(stderr, "kernel_launch: hipFuncSetAttribute failed\n"); grid = -1; return; }
        if (hipOccupancyMaxActiveBlocksPerMultiprocessor(&per_cu, (const void*)trunk_fwd, NWAVES * 64, LDS_BYTES) != hipSuccess || per_cu < 1) fprintf(stderr, "kernel_launch: occupancy query reports %d workgroups per CU\n", per_cu);
        (void)hipGetLastError();
        grid = cus;
    }
    if (grid < 0) return;
    if (hipMemsetAsync((char*)d_ws + WS_CTL, 0, CTL_ZERO_BYTES, stream) != hipSuccess) { fprintf(stderr, "kernel_launch: hipMemsetAsync failed\n"); return; }
    Args a{};
    for (int i = 0; i < 17; ++i) a.in[i] = (const float*)d_in[i];
    a.out = (float*)d_out; a.ws = (unsigned char*)d_ws;
    if (N_LAUNCHES == 1) {
        a.ph_lo = 0; a.ph_hi = NPH;
        void* kargs[] = {&a};
        const hipError_t e = hipLaunchCooperativeKernel((const void*)trunk_fwd, dim3(grid), dim3(NWAVES * 64), kargs, LDS_BYTES, stream);
        if (e != hipSuccess) fprintf(stderr, "kernel_launch: cooperative launch failed: %s (grid %d)\n", hipGetErrorString(e), grid);
    } else {
        for (int li = 0; li < NPH; ++li) { a.ph_lo = li; a.ph_hi = li + 1;
            hipLaunchKernelGGL(trunk_fwd, dim3(grid), dim3(NWAVES * 64), LDS_BYTES, stream, a);
            const hipError_t le = hipPeekAtLastError();
            if (le != hipSuccess) { fprintf(stderr, "kernel_launch: launch %d failed: %s\n", li, hipGetErrorName(le)); break; } }
    }
}
```

```cpp
#include <hip/hip_runtime.h>
#include <cstdio>
#include <cstdint>
__device__ __forceinline__ int mk_lane_id() { int l; asm volatile("v_mbcnt_lo_u32_b32 %0, -1, 0\n\tv_mbcnt_hi_u32_b32 %0, -1, %0" : "=v"(l)); return l; }
namespace pg8 {
#define PG8_LAS __attribute__((address_space(3)))
typedef unsigned short bf16_t;
typedef short bf16x8 __attribute__((ext_vector_type(8)));
typedef float f32x4 __attribute__((ext_vector_type(4)));
typedef unsigned u32x4 __attribute__((ext_vector_type(4)));
constexpr int BM = 256, BK = 64, HALF = 128, HTB = HALF * BK * 2  , STAGE_BYTES = 8 * HTB, NXCD = 8, WGM = 8;

__host__ __device__ __forceinline__ int lds_byte(int r, int c) { const int st = (r >> 4) * 2 + (c >> 5), rr = r & 15, cc = c & 31, ob = rr * 64 + cc * 2; return st * 1024 + (ob ^ (((ob >> 9) & 1) << 5)); }
__host__ __device__ __forceinline__ void stage_rc(int b, int& R, int& C) { const int st = b / 1024, sb = b % 1024, swz = sb ^ (((sb >> 9) & 1) << 5); R = (st >> 1) * 16 + swz / 64; C = (st & 1) * 32 + (swz % 64) / 2; }
__host__ __device__ __forceinline__ int perm32(int rho) { const int n = rho >> 4, i = rho & 15; return 8 * (i >> 2) + 4 * n + (i & 3); }

struct Unit { int pm, pn; };
struct Gemm { const bf16_t* A; const bf16_t* Bt; int M, N, K; };

struct StaticOrder {
    int nM, nN, nwg, G, c;
    __host__ __device__ void init(int M, int N, int G_, int c_) { nM = M / BM; nN = N / BM; nwg = nM * nN; G = G_; c = c_; }
    __host__ __device__ bool next(int i, Unit& u) const {
        const long L = (long)i * G + c; if (L >= nwg) return false;
        int wgid = (int)L; { const int q = nwg / NXCD, r = nwg % NXCD, xcd = wgid % NXCD, off = wgid / NXCD; wgid = (xcd < r ? xcd * (q + 1) : r * (q + 1) + (xcd - r) * q) + off; }
        const int nig = WGM * nN, gid = wgid / nig, fm = gid * WGM, gsz = (nM - fm) < WGM ? (nM - fm) : WGM;
        u.pm = fm + ((wgid % nig) % gsz); u.pn = (wgid % nig) / gsz; return true;
    }
    __device__ __forceinline__ void a_ready(const Unit&) const {}
    __device__ __forceinline__ void done(const Unit&) const {}
};

__device__ __forceinline__ unsigned cvt_pk_bf16(float lo, float hi) { unsigned r; asm volatile("v_cvt_pk_bf16_f32 %0, %1, %2" : "=v"(r) : "v"(lo), "v"(hi)); return r; }
typedef float f32x2 __attribute__((ext_vector_type(2)));
__device__ __forceinline__ f32x2 gelu_pk(f32x2 v) {
    const f32x2 av = __builtin_elementwise_abs(v), d = av * 0.2316418882f + 1.0f;
    f32x2 t; t.x = __builtin_amdgcn_rcpf(d.x); t.y = __builtin_amdgcn_rcpf(d.y);
    f32x2 q = t * 0.5307027145f + (-0.7265760135f); q = q * t + 0.7107068705f; q = q * t + (-0.142248368f); q = q * t + 0.127414796f; q = q * t;
    const f32x2 s = (v * v) * (-0.72134752044f);
    f32x2 e; e.x = __builtin_amdgcn_exp2f(s.x); e.y = __builtin_amdgcn_exp2f(s.y);
    const f32x2 m = v * (q * e), r = v - m;
    f32x2 o; o.x = v.x < 0.f ? m.x : r.x; o.y = v.y < 0.f ? m.y : r.y; return o;
}

template <int ACT  > struct EpiBf16 {
    static constexpr bool PERM = true, AFTER_DRAIN = false; static_assert(ACT == 0 || ACT == 1, "EpiBf16: ACT is 0 (none) or 1 (gelu_pk)");
    bf16_t* O; int ldc; const float* bias; int split_cols; size_t split_stride; float scale0;
    __device__ __forceinline__ void operator()(const f32x4 (&acc)[2][2][4][2], const Unit& u, int wr, int wc, int fr, int fq) const {
        const int row0 = u.pm * BM + wr * 64 + fr; int colt = u.pn * BM; bf16_t* base = O;
        float sc = 1.f; if (split_cols) { const int t = colt / split_cols; base += (size_t)t * split_stride; colt -= t * split_cols; if (t == 0) sc = scale0; }
        const int col0 = colt + wc * 32 + 8 * fq, bcol0 = u.pn * BM + wc * 32 + 8 * fq;
        f32x4 bv[2][2];
#pragma unroll
        for (int bj = 0; bj < 2; ++bj)
#pragma unroll
            for (int n = 0; n < 2; ++n) bv[bj][n] = bias ? *(const f32x4*)(bias + bcol0 + bj * HALF + 4 * n) : (f32x4){0.f, 0.f, 0.f, 0.f};
#pragma unroll
        for (int ai = 0; ai < 2; ++ai)
#pragma unroll
            for (int m = 0; m < 4; ++m) { bf16_t* rowp = base + (size_t)(row0 + ai * HALF + m * 16) * ldc + col0;
#pragma unroll
                for (int bj = 0; bj < 2; ++bj) { f32x4 v0 = acc[ai][bj][m][0] + bv[bj][0], v1 = acc[ai][bj][m][1] + bv[bj][1];
                    if (ACT == 1) { f32x2 a = gelu_pk((f32x2){v0[0], v0[1]}), b = gelu_pk((f32x2){v0[2], v0[3]}), c = gelu_pk((f32x2){v1[0], v1[1]}), d = gelu_pk((f32x2){v1[2], v1[3]});
                        v0 = (f32x4){a.x, a.y, b.x, b.y}; v1 = (f32x4){c.x, c.y, d.x, d.y}; }
                    v0 = v0 * sc; v1 = v1 * sc; u32x4 w; w.x = cvt_pk_bf16(v0[0], v0[1]); w.y = cvt_pk_bf16(v0[2], v0[3]); w.z = cvt_pk_bf16(v1[0], v1[1]); w.w = cvt_pk_bf16(v1[2], v1[3]);
                    *(u32x4*)(rowp + bj * HALF) = w; } }
    }
};

struct PanelStats {
    unsigned* xbuf;
    unsigned* cnt;
    unsigned* tmo;
    int ntn; float eps;
    unsigned code;
    __device__ __forceinline__ bool run(const f32x4 (&v)[2][2][4][2], const Unit& u, int wr, int wc, int fr, int fq, PG8_LAS unsigned char* lds, int wid, int lane) const {
        typedef float f32x2v __attribute__((ext_vector_type(2)));
        PG8_LAS f32x2v* P = (PG8_LAS f32x2v*)lds;
        PG8_LAS f32x2v* S = (PG8_LAS f32x2v*)(lds + 8192);
        PG8_LAS unsigned* flag = (PG8_LAS unsigned*)(lds + 8192 + 2048);
#pragma unroll
        for (int ai = 0; ai < 2; ++ai)
#pragma unroll
            for (int m = 0; m < 4; ++m) {
                float s = 0.f;
#pragma unroll
                for (int bj = 0; bj < 2; ++bj)
#pragma unroll
                    for (int n = 0; n < 2; ++n) { const f32x4 x = v[ai][bj][m][n]; s += (x[0] + x[1]) + (x[2] + x[3]); }
                s += __shfl_xor(s, 16); s += __shfl_xor(s, 32);
                const float mw = s * (1.0f / 64.0f); float q = 0.f;
#pragma unroll
                for (int bj = 0; bj < 2; ++bj)
#pragma unroll
                    for (int n = 0; n < 2; ++n) { const f32x4 d = v[ai][bj][m][n] - mw; q += (d[0] * d[0] + d[1] * d[1]) + (d[2] * d[2] + d[3] * d[3]); }
                q += __shfl_xor(q, 16); q += __shfl_xor(q, 32);
                if (fq == 0) P[(ai * HALF + wr * 64 + m * 16 + fr) * 4 + wc] = (f32x2v){mw, q};
            }
        asm volatile("s_waitcnt lgkmcnt(0)" ::: "memory"); __builtin_amdgcn_s_barrier(); asm volatile("" ::: "memory");
        const int row = wid * 32 + (lane & 31);
        unsigned long long* slots = (unsigned long long*)xbuf + (size_t)(u.pm * BM + row) * 4;
        if (wid == 0 && lane == 0) flag[0] = 0u;
        if (lane < 32) {
            const f32x2v a = P[row * 4 + 0], b = P[row * 4 + 1], c = P[row * 4 + 2], d = P[row * 4 + 3];
            const float mt = (a.x + b.x + c.x + d.x) * 0.25f;
            const float da = a.x - mt, db = b.x - mt, dc = c.x - mt, dd = d.x - mt;
            const float m2 = (a.y + b.y) + (c.y + d.y) + 64.0f * ((da * da + db * db) + (dc * dc + dd * dd));
            __hip_atomic_store(slots + u.pn, ((unsigned long long)(__float_as_uint(m2) | 1u) << 32) | __float_as_uint(mt), __ATOMIC_RELAXED, __HIP_MEMORY_SCOPE_AGENT);
        }
        if (lane < 32) {
            unsigned long long w[4]; unsigned spins = 0u; bool dead = false;
            for (;;) {
                bool all = true;
#pragma unroll
                for (int t = 0; t < 4; ++t) { w[t] = (t < ntn) ? __hip_atomic_load(slots + t, __ATOMIC_RELAXED, __HIP_MEMORY_SCOPE_AGENT) : 1ull; all = all && (w[t] != 0ull); }
#if defined(BROKEN_EXCHANGE_NO_WAIT)
                break;
#endif
                if (all) break;
                if (++spins > (1u << 16)) { dead = true; break; }
                __builtin_amdgcn_s_sleep(2);
            }
            if (dead) { unsigned expect = 0u; __hip_atomic_compare_exchange_strong(tmo + 1, &expect, code | (unsigned)(u.pm & 0xff), __ATOMIC_RELAXED, __ATOMIC_RELAXED, __HIP_MEMORY_SCOPE_AGENT);
                        __hip_atomic_store(tmo, 1u, __ATOMIC_RELAXED, __HIP_MEMORY_SCOPE_AGENT); flag[0] = 1u; }
            float mt[4], m2[4]; float ms = 0.f;
#pragma unroll
            for (int t = 0; t < 4; ++t) { if (t < ntn) { mt[t] = __uint_as_float((unsigned)w[t]); m2[t] = __uint_as_float((unsigned)(w[t] >> 32)); } else { mt[t] = 0.f; m2[t] = 0.f; } ms += mt[t]; }
            const float mean = ms / (float)ntn; float q = 0.f;
#pragma unroll
            for (int t = 0; t < 4; ++t) if (t < ntn) { const float dm = mt[t] - mean; q += m2[t] + 256.0f * dm * dm; }
            S[row] = (f32x2v){mean, 1.0f / sqrtf(q / (256.0f * (float)ntn) + eps)};
        }
        asm volatile("s_waitcnt vmcnt(0) lgkmcnt(0)" ::: "memory"); __builtin_amdgcn_s_barrier(); asm volatile("" ::: "memory");
        const bool bad = flag[0] != 0u;
        return bad;
    }
};
struct EpiLnRes {
    static constexpr bool PERM = false, AFTER_DRAIN = true;
    const float* base; float* out; int ldc; const float* bias; PanelStats st; unsigned poison;
    __device__ __forceinline__ void fused(f32x4 (&acc)[2][2][4][2], const Unit& u, int wr, int wc, int fr, int fq, PG8_LAS unsigned char* lds, int wid, int lane) const {
        typedef float f32x2v __attribute__((ext_vector_type(2)));
        const PG8_LAS f32x2v* S = (const PG8_LAS f32x2v*)(lds + 8192);
        const int col0 = u.pn * BM + wc * 32 + 4 * fq;
#pragma unroll
        for (int bj = 0; bj < 2; ++bj)
#pragma unroll
            for (int n = 0; n < 2; ++n) { const f32x4 bv = bias ? *(const f32x4*)(bias + col0 + bj * HALF + n * 16) : (f32x4){0.f, 0.f, 0.f, 0.f};
#pragma unroll
                for (int ai = 0; ai < 2; ++ai)
#pragma unroll
                    for (int m = 0; m < 4; ++m) acc[ai][bj][m][n] += bv; }
        f32x4 pre[4][2][2];
#pragma unroll
        for (int m = 0; m < 4; ++m) { const size_t off = (size_t)(u.pm * BM + wr * 64 + m * 16 + fr) * ldc + col0;
#pragma unroll
            for (int bj = 0; bj < 2; ++bj)
#pragma unroll
                for (int n = 0; n < 2; ++n) pre[m][bj][n] = *(const f32x4*)(base + off + bj * HALF + n * 16); }
        const bool bad = st.run(acc, u, wr, wc, fr, fq, lds, wid, lane) || poison != 0u;
        const float qnan = __builtin_nanf("");
#pragma unroll
        for (int ai = 0; ai < 2; ++ai)
#pragma unroll
            for (int m = 0; m < 4; ++m) { const int r = ai * HALF + wr * 64 + m * 16 + fr; const f32x2v sr = S[r]; const size_t off = (size_t)(u.pm * BM + r) * ldc + col0;
#pragma unroll
                for (int bj = 0; bj < 2; ++bj)
#pragma unroll
                    for (int n = 0; n < 2; ++n) { const f32x4 bs = ai == 0 ? pre[m][bj][n] : *(const f32x4*)(base + off + bj * HALF + n * 16); f32x4 o = bs + (acc[ai][bj][m][n] - sr.x) * sr.y;
                        if (bad) o = (f32x4){qnan, qnan, qnan, qnan}; *(f32x4*)(out + off + bj * HALF + n * 16) = o; }
                if (m & 1) asm volatile("" ::: "memory"); }
    }
};
struct EpiLnResLn {
    static constexpr bool PERM = false, AFTER_DRAIN = true;
    const float* base; float* out; bf16_t* xn; int ldc; const float* bias; PanelStats st1, st2; unsigned poison;
    __device__ __forceinline__ void fused(f32x4 (&acc)[2][2][4][2], const Unit& u, int wr, int wc, int fr, int fq, PG8_LAS unsigned char* lds, int wid, int lane) const {
        typedef float f32x2v __attribute__((ext_vector_type(2))); typedef unsigned u32x2v __attribute__((ext_vector_type(2)));
        const PG8_LAS f32x2v* S = (const PG8_LAS f32x2v*)(lds + 8192);
        const int col0 = u.pn * BM + wc * 32 + 4 * fq;
#pragma unroll
        for (int bj = 0; bj < 2; ++bj)
#pragma unroll
            for (int n = 0; n < 2; ++n) { const f32x4 bv = bias ? *(const f32x4*)(bias + col0 + bj * HALF + n * 16) : (f32x4){0.f, 0.f, 0.f, 0.f};
#pragma unroll
                for (int ai = 0; ai < 2; ++ai)
#pragma unroll
                    for (int m = 0; m < 4; ++m) acc[ai][bj][m][n] += bv; }
        bool bad = st1.run(acc, u, wr, wc, fr, fq, lds, wid, lane) || poison != 0u;
        const float qnan = __builtin_nanf("");
#pragma unroll
        for (int ai = 0; ai < 2; ++ai)
#pragma unroll
            for (int m = 0; m < 4; ++m) { const int r = ai * HALF + wr * 64 + m * 16 + fr; const f32x2v sr = S[r]; const size_t off = (size_t)(u.pm * BM + r) * ldc + col0;
#pragma unroll
                for (int bj = 0; bj < 2; ++bj)
#pragma unroll
                    for (int n = 0; n < 2; ++n) { const f32x4 bs = *(const f32x4*)(base + off + bj * HALF + n * 16); acc[ai][bj][m][n] = bs + (acc[ai][bj][m][n] - sr.x) * sr.y; }
                asm volatile("" : "+v"(acc[ai][0][m][0]), "+v"(acc[ai][0][m][1]), "+v"(acc[ai][1][m][0]), "+v"(acc[ai][1][m][1]));
                if (m & 1) asm volatile("" ::: "memory"); }
        const bool bad1 = bad;
        bad = st2.run(acc, u, wr, wc, fr, fq, lds, wid, lane) || bad;
#pragma unroll
        for (int ai = 0; ai < 2; ++ai)
#pragma unroll
            for (int m = 0; m < 4; ++m) { const int r = ai * HALF + wr * 64 + m * 16 + fr; const f32x2v sr = S[r]; const size_t off = (size_t)(u.pm * BM + r) * ldc + col0;
#pragma unroll
                for (int bj = 0; bj < 2; ++bj)
#pragma unroll
                    for (int n = 0; n < 2; ++n) { const f32x4 x1 = acc[ai][bj][m][n]; *(f32x4*)(out + off + bj * HALF + n * 16) = bad1 ? (f32x4){qnan, qnan, qnan, qnan} : x1;
                        const f32x4 o = (x1 - sr.x) * sr.y; u32x2v w; w.x = cvt_pk_bf16(o[0], o[1]); w.y = cvt_pk_bf16(o[2], o[3]);
                        if (bad) { w.x = 0x7fc07fc0u; w.y = 0x7fc07fc0u; } *(u32x2v*)(xn + off + bj * HALF + n * 16) = w; }
                asm volatile("" ::: "memory"); }
    }
};

template <class Epi, class Sched, bool ALIGN_EPI = false, bool SP2 = false>
__device__ __forceinline__ void gemm_phase(PG8_LAS unsigned char* lds, const Gemm g, const Sched& S, const Epi& E, int wave_) {
    const int wid = __builtin_amdgcn_readfirstlane(wave_), lane = mk_lane_id(), tid = wid * 64 + lane, wr = wid >> 2, wc = wid & 3, fr = lane & 15, fq = lane >> 4;
    const int K = g.K, nt = K / BK;
    unsigned voffA[2], voffB[2];
#pragma unroll
    for (int i = 0; i < 2; ++i) { int R, C; stage_rc(tid * 16 + i * 8192, R, C); const int Rb = Epi::PERM ? ((R & ~31) + perm32(R & 31)) : R;
        voffA[i] = (unsigned)(R * K + C) * 2u; voffB[i] = (unsigned)(Rb * K + C) * 2u; }
    const size_t kstep = (size_t)(BK * 2);
    const size_t hstep = (size_t)HALF * K * 2;
    const size_t tstep = 2 * hstep;
    const unsigned ldsw = (unsigned)wid * 1024u;
    const int aoff = lds_byte(wr * 64 + fr, fq * 8), boff = lds_byte(wc * 32 + fr, fq * 8);
#define PG8_SA(b, h) (((b) * 2 + (h)) * HTB)
#define PG8_SB(b, h) ((4 + (b) * 2 + (h)) * HTB)
#define PG8_STAGE(bufoff, gbase, voff) do { _Pragma("unroll") for (int _i = 0; _i < 2; ++_i) \
        __builtin_amdgcn_global_load_lds((const unsigned*)((const char*)(gbase) + (voff)[_i]), (PG8_LAS unsigned*)(lds + (bufoff) + ldsw + _i * 8192), 16, 0, 0); } while (0)
#define PG8_LDA(dst, b, h) do { _Pragma("unroll") for (int m = 0; m < 4; ++m) _Pragma("unroll") for (int k = 0; k < 2; ++k) dst[m][k] = *(const PG8_LAS bf16x8*)(lds + PG8_SA(b, h) + aoff + m * 2048 + k * 1024); } while (0)
#define PG8_LDB(dst, b, h) do { _Pragma("unroll") for (int n = 0; n < 2; ++n) _Pragma("unroll") for (int k = 0; k < 2; ++k) dst[n][k] = *(const PG8_LAS bf16x8*)(lds + PG8_SB(b, h) + boff + n * 2048 + k * 1024); } while (0)
#define PG8_MMA(ai, bj, At, Bt) do { __builtin_amdgcn_s_setprio(1); _Pragma("unroll") for (int m = 0; m < 4; ++m) _Pragma("unroll") for (int n = 0; n < 2; ++n) _Pragma("unroll") for (int k = 0; k < 2; ++k) \
        acc[ai][bj][m][n] = __builtin_amdgcn_mfma_f32_16x16x32_bf16(Bt[n][k], At[m][k], acc[ai][bj][m][n], 0, 0, 0); __builtin_amdgcn_s_setprio(0); } while (0)
#define PG8_WAIT_V(n) asm volatile("s_waitcnt vmcnt(" #n ")" ::: "memory")
#define PG8_WAIT_L(n) asm volatile("s_waitcnt lgkmcnt(" #n ")" ::: "memory")
#define PG8_BAR __builtin_amdgcn_s_barrier()
#define PG8_SCHED __builtin_amdgcn_sched_barrier(0)
    Unit cur, nxt; int ui = 0;
    if (!S.next(0, cur)) return;
    f32x4 acc[2][2][4][2];
#pragma unroll
    for (int a = 0; a < 2; ++a)
#pragma unroll
        for (int b = 0; b < 2; ++b)
#pragma unroll
            for (int m = 0; m < 4; ++m)
#pragma unroll
                for (int n = 0; n < 2; ++n) acc[a][b][m][n] = (f32x4){0.f, 0.f, 0.f, 0.f};
    bf16x8 At[4][2], B0[2][2], B1[2][2];
    const char* cA = (const char*)g.A + (size_t)cur.pm * tstep; const char* cB = (const char*)g.Bt + (size_t)cur.pn * tstep;
    S.a_ready(cur);
    if constexpr (SP2) {
        PG8_STAGE(PG8_SB(0, 0), cB, voffB); PG8_STAGE(PG8_SB(0, 1), cB + hstep, voffB); PG8_STAGE(PG8_SA(0, 0), cA, voffA); PG8_STAGE(PG8_SA(0, 1), cA + hstep, voffA);
        if (wr == 1) PG8_BAR;
        PG8_WAIT_V(2); PG8_BAR;
        PG8_STAGE(PG8_SB(1, 0), cB + kstep, voffB); PG8_STAGE(PG8_SA(1, 0), cA + kstep, voffA); PG8_STAGE(PG8_SB(1, 1), cB + hstep + kstep, voffB);
        PG8_WAIT_V(6); PG8_BAR;
    } else {
        PG8_STAGE(PG8_SB(0, 0), cB, voffB); PG8_STAGE(PG8_SA(0, 0), cA, voffA); PG8_STAGE(PG8_SB(0, 1), cB + hstep, voffB); PG8_STAGE(PG8_SA(0, 1), cA + hstep, voffA);
        if (wr == 1) PG8_BAR;
        PG8_WAIT_V(4); PG8_BAR;
        PG8_STAGE(PG8_SB(1, 0), cB + kstep, voffB); PG8_STAGE(PG8_SA(1, 0), cA + kstep, voffA); PG8_STAGE(PG8_SB(1, 1), cB + hstep + kstep, voffB);
        PG8_WAIT_V(6); PG8_BAR;
    }
    for (;;) {
        const bool has_next = S.next(ui + 1, nxt);
        const char* nA = has_next ? (const char*)g.A + (size_t)nxt.pm * tstep : cA; const char* nB = has_next ? (const char*)g.Bt + (size_t)nxt.pn * tstep : cB;
        for (int t = 0; t < nt; t += 2) {
            const bool last = (t == nt - 2);
            const char* a1 = cA + (size_t)(t + 1) * kstep;
            const char* a2 = last ? nA : cA + (size_t)(t + 2) * kstep; const char* b2 = last ? nB : cB + (size_t)(t + 2) * kstep;
            const char* a3 = a2 + kstep; const char* b3 = b2 + kstep;
            if (last && has_next) S.a_ready(nxt);
            if constexpr (SP2) {
            PG8_LDB(B0, 0, 0); PG8_LDB(B1, 0, 1); PG8_SCHED; PG8_LDA(At, 0, 0); PG8_STAGE(PG8_SA(1, 1), a1 + hstep, voffA);
            PG8_WAIT_V(8); PG8_WAIT_L(0); PG8_BAR; PG8_MMA(0, 0, At, B0); PG8_MMA(0, 1, At, B1); PG8_BAR; PG8_SCHED;
            PG8_LDA(At, 0, 1); PG8_STAGE(PG8_SB(0, 0), b2, voffB); PG8_STAGE(PG8_SB(0, 1), b2 + hstep, voffB); PG8_STAGE(PG8_SA(0, 0), a2, voffA);
            PG8_WAIT_V(8); PG8_WAIT_L(0); PG8_BAR; PG8_MMA(1, 0, At, B0); PG8_MMA(1, 1, At, B1); PG8_BAR; PG8_SCHED;
            PG8_LDB(B0, 1, 0); PG8_LDB(B1, 1, 1); PG8_SCHED; PG8_LDA(At, 1, 0); PG8_STAGE(PG8_SA(0, 1), a2 + hstep, voffA);
            PG8_WAIT_V(8); PG8_WAIT_L(0); PG8_BAR; PG8_MMA(0, 0, At, B0); PG8_MMA(0, 1, At, B1); PG8_BAR; PG8_SCHED;
            PG8_LDA(At, 1, 1); PG8_STAGE(PG8_SB(1, 0), b3, voffB); PG8_STAGE(PG8_SB(1, 1), b3 + hstep, voffB); PG8_STAGE(PG8_SA(1, 0), a3, voffA);
            PG8_WAIT_V(8); PG8_WAIT_L(0); PG8_BAR; PG8_MMA(1, 0, At, B0); PG8_MMA(1, 1, At, B1); PG8_BAR; PG8_SCHED;
            } else {
            PG8_LDB(B0, 0, 0); PG8_SCHED; PG8_LDA(At, 0, 0); PG8_STAGE(PG8_SA(1, 1), a1 + hstep, voffA);
            PG8_WAIT_L(8); PG8_BAR; PG8_WAIT_L(0); PG8_MMA(0, 0, At, B0); PG8_BAR; PG8_SCHED;
            PG8_LDB(B1, 0, 1); PG8_STAGE(PG8_SB(0, 0), b2, voffB);
            PG8_BAR; PG8_WAIT_L(0); PG8_MMA(0, 1, At, B1); PG8_BAR;
            PG8_LDA(At, 0, 1); PG8_STAGE(PG8_SA(0, 0), a2, voffA);
            PG8_BAR; PG8_WAIT_L(0); PG8_MMA(1, 0, At, B0); PG8_BAR; PG8_SCHED;
            PG8_STAGE(PG8_SB(0, 1), b2 + hstep, voffB);
            PG8_WAIT_V(6); PG8_BAR; PG8_MMA(1, 1, At, B1); PG8_BAR;
            PG8_LDB(B0, 1, 0); PG8_SCHED; PG8_LDA(At, 1, 0); PG8_STAGE(PG8_SA(0, 1), a2 + hstep, voffA);
            PG8_WAIT_L(8); PG8_BAR; PG8_WAIT_L(0); PG8_MMA(0, 0, At, B0); PG8_BAR; PG8_SCHED;
            PG8_LDB(B1, 1, 1); PG8_STAGE(PG8_SB(1, 0), b3, voffB);
            PG8_BAR; PG8_WAIT_L(0); PG8_MMA(0, 1, At, B1); PG8_BAR;
            PG8_LDA(At, 1, 1); PG8_STAGE(PG8_SA(1, 0), a3, voffA);
            PG8_BAR; PG8_WAIT_L(0); PG8_MMA(1, 0, At, B0); PG8_BAR; PG8_SCHED;
            PG8_STAGE(PG8_SB(1, 1), b3 + hstep, voffB);
            PG8_WAIT_V(6); PG8_BAR; PG8_MMA(1, 1, At, B1); PG8_BAR;
            }
        }
        if constexpr (ALIGN_EPI) { if (wr == 0) PG8_BAR; }
        if constexpr (!Epi::AFTER_DRAIN) { E(acc, cur, wr, wc, fr, fq); S.done(cur); }
        if (!has_next) break;
#pragma unroll
        for (int a = 0; a < 2; ++a)
#pragma unroll
            for (int b = 0; b < 2; ++b)
#pragma unroll
                for (int m = 0; m < 4; ++m)
#pragma unroll
                    for (int n = 0; n < 2; ++n) acc[a][b][m][n] = (f32x4){0.f, 0.f, 0.f, 0.f};
        cur = nxt; cA = nA; cB = nB; ++ui;
        if constexpr (ALIGN_EPI) { if (wr == 1) PG8_BAR; }
    }
    PG8_WAIT_V(0);
    if constexpr (!ALIGN_EPI) { if (wr == 0) PG8_BAR; }
    PG8_BAR;
    if constexpr (Epi::AFTER_DRAIN) { E.fused(acc, cur, wr, wc, fr, fq, lds, wid, lane); S.done(cur); }
#undef PG8_SA
#undef PG8_SB
#undef PG8_STAGE
#undef PG8_LDA
#undef PG8_LDB
#undef PG8_MMA
#undef PG8_WAIT_V
#undef PG8_WAIT_L
#undef PG8_BAR
#undef PG8_SCHED
}
}


namespace pg8 {
struct EpiBf16QK {
    static constexpr bool PERM = true, AFTER_DRAIN = false;
    bf16_t* O; int ldc; int split_cols; size_t split_stride; unsigned* nrm;
    __device__ __forceinline__ void operator()(const f32x4 (&acc)[2][2][4][2], const Unit& u, int wr, int wc, int fr, int fq) const {
        const int row0 = u.pm * BM + wr * 64 + fr; int colt = u.pn * BM; bf16_t* base = O;
        { const int t = colt / split_cols; base += (size_t)t * split_stride; colt -= t * split_cols; }
        const int col0 = colt + wc * 32 + 8 * fq;
        float pmax[2] = {0.f, 0.f};
#pragma unroll
        for (int ai = 0; ai < 2; ++ai)
#pragma unroll
            for (int m = 0; m < 4; ++m) { bf16_t* rowp = base + (size_t)(row0 + ai * HALF + m * 16) * ldc + col0;
#pragma unroll
                for (int bj = 0; bj < 2; ++bj) { const f32x4 v0 = acc[ai][bj][m][0], v1 = acc[ai][bj][m][1];
                    u32x4 w; w.x = cvt_pk_bf16(v0[0], v0[1]); w.y = cvt_pk_bf16(v0[2], v0[3]); w.z = cvt_pk_bf16(v1[0], v1[1]); w.w = cvt_pk_bf16(v1[2], v1[3]);
                    *(u32x4*)(rowp + bj * HALF) = w;
                    if (u.pn < 4) { float ss = (v0[0] * v0[0] + v0[1] * v0[1]) + (v0[2] * v0[2] + v0[3] * v0[3]) + (v1[0] * v1[0] + v1[1] * v1[1]) + (v1[2] * v1[2] + v1[3] * v1[3]);
                        ss += __shfl_xor(ss, 16); ss += __shfl_xor(ss, 32); pmax[bj] = fmaxf(pmax[bj], ss); } } }
        if (u.pn < 4) {
#pragma unroll
            for (int bj = 0; bj < 2; ++bj) { float v = pmax[bj];
#pragma unroll
                for (int o = 1; o < 16; o <<= 1) v = fmaxf(v, __shfl_xor(v, o));
                if (fr == 0 && fq == 0) atomicMax(nrm + (u.pn >> 1) * 32 + (u.pm >> 5) * 8 + 4 * (u.pn & 1) + 2 * bj + (wc >> 1), __float_as_uint(v * 1.02f)); }
        }
    }
};
}

namespace pg8 {
struct EpiBf16VT {
    static constexpr bool PERM = true, AFTER_DRAIN = false;
    bf16_t* O; int ldc; float* part;
    __device__ __forceinline__ void operator()(const f32x4 (&acc)[2][2][4][2], const Unit& u, int wr, int wc, int fr, int fq) const {
        const int row0 = u.pm * BM + wr * 64 + fr, col0 = u.pn * BM + wc * 32 + 8 * fq;
#pragma unroll
        for (int bj = 0; bj < 2; ++bj) {
            float ps[8], pq[8];
#pragma unroll
            for (int e = 0; e < 8; ++e) { ps[e] = 0.f; pq[e] = 0.f; }
#pragma unroll
            for (int ai = 0; ai < 2; ++ai)
#pragma unroll
                for (int m = 0; m < 4; ++m) { bf16_t* rowp = O + (size_t)(row0 + ai * HALF + m * 16) * ldc + col0;
                    f32x4 v0 = acc[ai][bj][m][0], v1 = acc[ai][bj][m][1];
                    { f32x2 a = gelu_pk((f32x2){v0[0], v0[1]}), b = gelu_pk((f32x2){v0[2], v0[3]}), c = gelu_pk((f32x2){v1[0], v1[1]}), d = gelu_pk((f32x2){v1[2], v1[3]});
                      v0 = (f32x4){a.x, a.y, b.x, b.y}; v1 = (f32x4){c.x, c.y, d.x, d.y}; }
#pragma unroll
                    for (int e = 0; e < 4; ++e) { ps[e] += v0[e]; pq[e] += v0[e] * v0[e]; ps[4 + e] += v1[e]; pq[4 + e] += v1[e] * v1[e]; }
                    u32x4 w; w.x = cvt_pk_bf16(v0[0], v0[1]); w.y = cvt_pk_bf16(v0[2], v0[3]); w.z = cvt_pk_bf16(v1[0], v1[1]); w.w = cvt_pk_bf16(v1[2], v1[3]);
                    *(u32x4*)(rowp + bj * HALF) = w; }
            { const bool b3 = (fr & 8) != 0, b2 = (fr & 4) != 0, b1 = (fr & 2) != 0, b0 = (fr & 1) != 0;
              float t8[8], t4[4], t2[2];
#pragma unroll
              for (int i = 0; i < 8; ++i) { const float keep = b3 ? pq[i] : ps[i], send = b3 ? ps[i] : pq[i]; t8[i] = keep + __shfl_xor(send, 8); }
#pragma unroll
              for (int i = 0; i < 4; ++i) { const float keep = b2 ? t8[4 + i] : t8[i], send = b2 ? t8[i] : t8[4 + i]; t4[i] = keep + __shfl_xor(send, 4); }
#pragma unroll
              for (int i = 0; i < 2; ++i) { const float keep = b1 ? t4[2 + i] : t4[i], send = b1 ? t4[i] : t4[2 + i]; t2[i] = keep + __shfl_xor(send, 2); }
              const float t1 = (b0 ? t2[1] : t2[0]) + __shfl_xor(b0 ? t2[0] : t2[1], 1);
              const int e = (fr & 7);
              part[((size_t)(col0 + bj * HALF + e) * 8 + 2 * u.pm + wr) * 2 + (b3 ? 1 : 0)] = t1; }
        }
    }
};
}

#ifndef PG8_SP2
#define PG8_SP2 true
#endif
#ifndef PG8_ALIGN
#define PG8_ALIGN true
#endif
namespace pg8 {
struct EpiSwiGLU {
    static constexpr bool PERM = true, AFTER_DRAIN = false;
    bf16_t* O; int ldc;
    __device__ __forceinline__ void operator()(const f32x4 (&acc)[2][2][4][2], const Unit& u, int wr, int wc, int fr, int fq) const {
        const int row0 = u.pm * BM + wr * 64 + fr, col0 = u.pn * HALF + wc * 32 + 8 * fq;
#pragma unroll
        for (int ai = 0; ai < 2; ++ai)
#pragma unroll
            for (int m = 0; m < 4; ++m) { bf16_t* rowp = O + (size_t)(row0 + ai * HALF + m * 16) * ldc + col0;
                f32x4 h[2];
#pragma unroll
                for (int n = 0; n < 2; ++n) { const f32x4 g = acc[ai][0][m][n], up = acc[ai][1][m][n];
#pragma unroll
                    for (int e = 0; e < 4; ++e) { const float ex = __builtin_amdgcn_exp2f(g[e] * (-1.4426950408889634f)); h[n][e] = g[e] * up[e] * __builtin_amdgcn_rcpf(1.0f + ex); } }
                u32x4 w; w.x = cvt_pk_bf16(h[0][0], h[0][1]); w.y = cvt_pk_bf16(h[0][2], h[0][3]); w.z = cvt_pk_bf16(h[1][0], h[1][1]); w.w = cvt_pk_bf16(h[1][2], h[1][3]);
                *(u32x4*)rowp = w; }
    }
};
struct EpiLnAff {
    static constexpr bool PERM = true, AFTER_DRAIN = true;
    const float* base; const bf16_t* basebf; float* out; bf16_t* xn; int ldc; const float* gam; const float* bet; float alpha; PanelStats st; unsigned poison;
    __device__ __forceinline__ void fused(f32x4 (&acc)[2][2][4][2], const Unit& u, int wr, int wc, int fr, int fq, PG8_LAS unsigned char* lds, int wid, int lane) const {
        typedef float f32x2v __attribute__((ext_vector_type(2)));
        const PG8_LAS f32x2v* S = (const PG8_LAS f32x2v*)(lds + 8192);
        const int col0 = u.pn * BM + wc * 32 + 8 * fq;
#pragma unroll
        for (int ai = 0; ai < 2; ++ai)
#pragma unroll
            for (int m = 0; m < 4; ++m) { const size_t off = (size_t)(u.pm * BM + ai * HALF + wr * 64 + m * 16 + fr) * ldc + col0;
#pragma unroll
                for (int bj = 0; bj < 2; ++bj) { f32x4 b0, b1;
                    if (basebf) { const u32x4 w = *(const u32x4*)(basebf + off + bj * HALF);
                        b0[0] = __builtin_bit_cast(float, w.x << 16); b0[1] = __builtin_bit_cast(float, w.x & 0xffff0000u); b0[2] = __builtin_bit_cast(float, w.y << 16); b0[3] = __builtin_bit_cast(float, w.y & 0xffff0000u);
                        b1[0] = __builtin_bit_cast(float, w.z << 16); b1[1] = __builtin_bit_cast(float, w.z & 0xffff0000u); b1[2] = __builtin_bit_cast(float, w.w << 16); b1[3] = __builtin_bit_cast(float, w.w & 0xffff0000u); }
                    else { b0 = *(const f32x4*)(base + off + bj * HALF); b1 = *(const f32x4*)(base + off + bj * HALF + 4); }
                    acc[ai][bj][m][0] = b0 * alpha + acc[ai][bj][m][0]; acc[ai][bj][m][1] = b1 * alpha + acc[ai][bj][m][1]; }
                asm volatile("" : "+v"(acc[ai][0][m][0]), "+v"(acc[ai][0][m][1]), "+v"(acc[ai][1][m][0]), "+v"(acc[ai][1][m][1]));
                if (basebf ? (m == 3) : (m & 1)) asm volatile("" ::: "memory"); }
        const bool bad = st.run(acc, u, wr, wc, fr, fq, lds, wid, lane) || poison != 0u;
        const float qnan = __builtin_nanf("");
        f32x4 gv[2][2], bv[2][2];
#pragma unroll
        for (int bj = 0; bj < 2; ++bj)
#pragma unroll
            for (int n = 0; n < 2; ++n) { gv[bj][n] = *(const f32x4*)(gam + col0 + bj * HALF + n * 4); bv[bj][n] = *(const f32x4*)(bet + col0 + bj * HALF + n * 4); }
#pragma unroll
        for (int ai = 0; ai < 2; ++ai)
#pragma unroll
            for (int m = 0; m < 4; ++m) { const int r = ai * HALF + wr * 64 + m * 16 + fr; const f32x2v sr = S[r]; const size_t off = (size_t)(u.pm * BM + r) * ldc + col0;
#pragma unroll
                for (int bj = 0; bj < 2; ++bj) { f32x4 o0 = (acc[ai][bj][m][0] - sr.x) * sr.y * gv[bj][0] + bv[bj][0], o1 = (acc[ai][bj][m][1] - sr.x) * sr.y * gv[bj][1] + bv[bj][1];
                    if (bad) { o0 = (f32x4){qnan, qnan, qnan, qnan}; o1 = o0; }
                    if (out) { __builtin_nontemporal_store(o0, (f32x4*)(out + off + bj * HALF)); __builtin_nontemporal_store(o1, (f32x4*)(out + off + bj * HALF + 4)); }
                    if (xn) { u32x4 w; w.x = cvt_pk_bf16(o0[0], o0[1]); w.y = cvt_pk_bf16(o0[2], o0[3]); w.z = cvt_pk_bf16(o1[0], o1[1]); w.w = cvt_pk_bf16(o1[2], o1[3]); *(u32x4*)(xn + off + bj * HALF) = w; } }
                asm volatile("" ::: "memory"); }
    }
};
}
#include <hip/hip_bf16.h>
#include <cmath>
namespace attn_body {
using bf16=__hip_bfloat16;
using bf16x8=__attribute__((ext_vector_type(8)))short;
using s16x4=__attribute__((ext_vector_type(4)))short;
using f32x16=__attribute__((ext_vector_type(16)))float;
using u32x4=__attribute__((ext_vector_type(4)))unsigned;
using f32x4_t=__attribute__((ext_vector_type(4)))float;
constexpr int BATCH=4,NHEAD=8,SEQ=8192,D=64,DM=1024;
constexpr int NW=8,QBLK=32,QB=QBLK*NW,KVBLK=64,NQB=SEQ/QB;
constexpr int ATTN_PITCH=DM, ATTN_UNIT_ROWS=QB;
__device__ __forceinline__ int crow(int r,int hi){return (r&3)+8*(r>>2)+4*hi;}
#define SBAR() __builtin_amdgcn_sched_barrier(0)
__device__ __forceinline__ void cmask(f32x16&p0,f32x16&p1,int jb,int qrel,int hi){
  const float NEG=-INFINITY; int kb=64*jb+4*hi;
  #pragma unroll
  for(int r=0;r<16;++r){int kv=kb+(r&3)+8*(r>>2); if(kv>qrel)p0[r]=NEG; if(kv+32>qrel)p1[r]=NEG;}
}

constexpr int NSLOT=3, SLOTB=8192;
constexpr int LDS_K=0, LDS_V=NSLOT*SLOTB, LDS_WS=2*NSLOT*SLOTB, LDS_OST=LDS_WS+NW*64*4, LDS_CK=LDS_OST+NW*4096, LDS_BYTES=LDS_CK+SEQ*4;
constexpr float C2=0.125f*1.4426950408889634f;
__device__ __forceinline__ void glds16(const void*gsrc,unsigned lds_dst){unsigned keep;
  asm volatile("s_mov_b32 %0, m0\n\ts_mov_b32 m0, %2\n\ts_nop 0\n\tglobal_load_lds_dwordx4 %1, off\n\ts_mov_b32 m0, %0":"=&s"(keep):"v"(gsrc),"s"(lds_dst):"memory");}
__device__ __forceinline__ float max3f(float a,float b,float c){float r;asm("v_max3_f32 %0, %1, %2, %3":"=v"(r):"v"(a),"v"(b),"v"(c));return r;}
__device__ __forceinline__ float max2f(float a,float b){float r;asm("v_max_f32_e32 %0, %1, %2":"=v"(r):"v"(a),"v"(b));return r;}
__device__ __forceinline__ float fadd_s(float a,float b){float r;asm("v_add_f32_e32 %0, %1, %2":"=v"(r):"v"(a),"v"(b));return r;}
__device__ __forceinline__ float fsub_s(float a,float b){float r;asm("v_sub_f32_e32 %0, %1, %2":"=v"(r):"v"(a),"v"(b));return r;}
typedef float f32x2_t __attribute__((ext_vector_type(2))); typedef __bf16 bf16x2_t __attribute__((ext_vector_type(2)));
__device__ __forceinline__ unsigned cvtpk_s(float lo,float hi){f32x2_t v={lo,hi};bf16x2_t b=__builtin_convertvector(v,bf16x2_t);return __builtin_bit_cast(unsigned,b);}
#define WAIT_BAR(N) asm volatile("s_waitcnt vmcnt(" #N ") lgkmcnt(0)\n\ts_barrier":::"memory")

__device__ __forceinline__ void qkt(f32x16&p0,f32x16&p1,const char*Kslot,const bf16x8*qr,int r32,int hi){
  const char*kb=Kslot+hi*1024+r32*16;
  #pragma unroll
  for(int d0=0;d0<4;++d0){
    const bf16x8 b0=*reinterpret_cast<const bf16x8*>(kb+d0*2048);
    const bf16x8 b1=*reinterpret_cast<const bf16x8*>(kb+d0*2048+512);
    p0=__builtin_amdgcn_mfma_f32_32x32x16_bf16(b0,qr[d0],p0,0,0,0);p1=__builtin_amdgcn_mfma_f32_32x32x16_bf16(b1,qr[d0],p1,0,0,0);}
}
typedef __attribute__((address_space(3))) const char* lds_cptr;
typedef short v4i16_t __attribute__((ext_vector_type(4)));
__device__ __forceinline__ void kload8(bf16x8*kf,lds_cptr kp){
  kf[0]=*(const __attribute__((address_space(3))) bf16x8*)(kp);      kf[1]=*(const __attribute__((address_space(3))) bf16x8*)(kp+512);
  kf[2]=*(const __attribute__((address_space(3))) bf16x8*)(kp+2048); kf[3]=*(const __attribute__((address_space(3))) bf16x8*)(kp+2560);
  kf[4]=*(const __attribute__((address_space(3))) bf16x8*)(kp+4096); kf[5]=*(const __attribute__((address_space(3))) bf16x8*)(kp+4608);
  kf[6]=*(const __attribute__((address_space(3))) bf16x8*)(kp+6144); kf[7]=*(const __attribute__((address_space(3))) bf16x8*)(kp+6656);
}
__device__ __forceinline__ void kload2(bf16x8*kf,lds_cptr kp,int j){ kf[2*j]=*(const __attribute__((address_space(3))) bf16x8*)(kp+j*2048); kf[2*j+1]=*(const __attribute__((address_space(3))) bf16x8*)(kp+j*2048+512); }
__device__ __forceinline__ s16x4 vtr(lds_cptr p){ return __builtin_bit_cast(s16x4,__builtin_amdgcn_ds_read_tr16_b64_v4i16((__attribute__((address_space(3))) v4i16_t*)p)); }
__device__ __forceinline__ float rowmax(const f32x16&p0,const f32x16&p1){
  float a=max3f(p0[0],p0[1],p1[0]),b=max3f(p0[2],p0[3],p1[1]);a=max3f(a,p1[2],p1[3]);
  #pragma unroll
  for(int r=4;r<16;r+=4){a=max3f(a,p0[r],p0[r+1]);b=max3f(b,p0[r+2],p0[r+3]);a=max3f(a,p1[r],p1[r+1]);b=max3f(b,p1[r+2],p1[r+3]);}
  const float m=max2f(a,b);
  auto rr=__builtin_amdgcn_permlane32_swap(__float_as_uint(m),__float_as_uint(m),false,false);
  return max2f(__uint_as_float(rr[0]),__uint_as_float(rr[1]));
}
__device__ __forceinline__ void pv(f32x16*o,int vb,bf16x8 pa0,bf16x8 pa1,bf16x8 pa2,bf16x8 pa3){
  #pragma unroll
  for(int d0=0;d0<2;++d0){s16x4 lo[4],hi[4];
    #pragma unroll
    for(int ks=0;ks<4;++ks){
      asm volatile("ds_read_b64_tr_b16 %0,%1 offset:%c2":"=&v"(lo[ks]):"v"(vb),"i"(d0*4096+ks*1024):"memory");
      asm volatile("ds_read_b64_tr_b16 %0,%1 offset:%c2":"=&v"(hi[ks]):"v"(vb),"i"(d0*4096+ks*1024+512):"memory");}
    asm volatile("s_waitcnt lgkmcnt(0)":::"memory");SBAR();
    #define PK(k) (bf16x8){lo[k][0],lo[k][1],lo[k][2],lo[k][3],hi[k][0],hi[k][1],hi[k][2],hi[k][3]}
    o[d0]=__builtin_amdgcn_mfma_f32_32x32x16_bf16(pa0,PK(0),o[d0],0,0,0);
    o[d0]=__builtin_amdgcn_mfma_f32_32x32x16_bf16(pa1,PK(1),o[d0],0,0,0);
    o[d0]=__builtin_amdgcn_mfma_f32_32x32x16_bf16(pa2,PK(2),o[d0],0,0,0);
    o[d0]=__builtin_amdgcn_mfma_f32_32x32x16_bf16(pa3,PK(3),o[d0],0,0,0);
    #undef PK
  }
}

__device__ __forceinline__ unsigned pack_hilo(float v){ const unsigned hb=cvtpk_s(v,0.f)&0xffffu; const float lo=v-__uint_as_float(hb<<16); return hb|(cvtpk_s(lo,0.f)<<16); }
__device__ __forceinline__ float unpack_hilo(unsigned w){ return __uint_as_float(w<<16)+__uint_as_float(w&0xffff0000u); }
typedef __attribute__((address_space(3))) const f32x4_t* lds_f4ptr;
__device__ __forceinline__ void ldbias_raw(f32x16&c0,f32x16&c1,lds_cptr ckp){
  #pragma unroll
  for(int g=0;g<4;++g){ const f32x4_t a=*(lds_f4ptr)(ckp+g*32), b=*(lds_f4ptr)(ckp+128+g*32);
    c0[4*g]=a[0];c0[4*g+1]=a[1];c0[4*g+2]=a[2];c0[4*g+3]=a[3]; c1[4*g]=b[0];c1[4*g+1]=b[1];c1[4*g+2]=b[2];c1[4*g+3]=b[3]; }
}
__device__ __forceinline__ void ldbias_fin(f32x16&c0,f32x16&c1,float cqm){
  #pragma unroll
  for(int r=0;r<16;++r){ c0[r]=cqm-c0[r]; c1[r]=cqm-c1[r]; }
}
#ifndef ATTN_STORE16
#define ATTN_STORE16(p,v) (*(u32x4*)(p)=(v))
#endif
template<int THRL> __device__ __forceinline__ void attn_unit(int b,int h,int qb,const bf16*Q,const bf16*__restrict__ K,const bf16*__restrict__ V,bf16*O,const float*__restrict__ CS,float skipthr,char*shm,int wave_,unsigned*qctr,unsigned&nxt_,bool lead_){
  const int wid=__builtin_amdgcn_readfirstlane(wave_),lane=mk_lane_id(),tid=wid*64+lane,r32=lane&31,hi=lane>>5;
  const long rowbase=(long)b*SEQ; const int q0=qb*QB;
  const bf16*Qw=Q+(rowbase+q0+wid*QBLK)*DM+h*D;
  const bf16*Kh=K+rowbase*DM+h*D,*Vh=V+rowbase*DM+h*D;
  const unsigned lds0=(unsigned)(uintptr_t)shm;
  float*wsf=(float*)(shm+LDS_WS)+wid*64;
  const bf16*ksrc=Kh+(long)lane*DM+wid*8;
  const bf16*vsrc=Vh+(long)(16*(wid&3)+(lane>>2))*DM+(wid>>2)*32+(lane&3)*8;
  const unsigned kdst=lds0+LDS_K+wid*1024, vdst=lds0+LDS_V+wid*1024;
  #define DMA_K(t,slot) glds16(ksrc+(long)(NT-1-(t))*KVBLK*DM,(unsigned)__builtin_amdgcn_readfirstlane(kdst+(slot)))
  #define DMA_V(t,slot) glds16(vsrc+(long)(NT-1-(t))*KVBLK*DM,(unsigned)__builtin_amdgcn_readfirstlane(vdst+(slot)))
  const int vb0=(int)(lds0+LDS_V)+((lane>>4)&1)*32+(lane&3)*8+(4*hi+((lane&15)>>2))*64;
  const char*Kbase=shm+LDS_K; bf16x8 kf[8];
  const lds_cptr shm3=(lds_cptr)shm; const lds_cptr kp0=shm3+LDS_K+hi*1024+r32*16; const lds_cptr vp0=shm3+LDS_V+((lane>>4)&1)*32+(lane&3)*8+(4*hi+((lane&15)>>2))*64;
  const int NT=(q0+QB)/KVBLK;
  const float*cgl=CS+(long)(b*NHEAD+h)*SEQ; const float cref=cgl[q0];
  f32x4_t cv[4];
  #pragma unroll
  for(int k=0;k<4;++k){ const int idx=tid+512*k; cv[k]=(4*idx<q0+QB)?*reinterpret_cast<const f32x4_t*>(cgl+4*idx):(f32x4_t){0.f,0.f,0.f,0.f}; }
  DMA_K(0,0);DMA_V(0,0);DMA_K(1,SLOTB);
  bf16x8 qr[4];
  #pragma unroll
  for(int d0=0;d0<4;++d0)qr[d0]=*reinterpret_cast<const bf16x8*>(&Qw[(long)r32*DM+d0*16+hi*8]);
  #pragma unroll
  for(int k=0;k<4;++k){ const int idx=tid+512*k; if(4*idx<q0+QB){ const f32x4_t e_=(cref-cv[k])*1.4426950408889634f; *(__attribute__((address_space(3))) u32x4*)(shm3+LDS_CK+16*idx)=(u32x4){pack_hilo(e_[0]),pack_hilo(e_[1]),pack_hilo(e_[2]),pack_hilo(e_[3])}; } }
  const lds_cptr cke=shm3+LDS_CK+4*r32;
  const unsigned qxw=hi?0u:0x3f803f80u; const bf16x8 qext=__builtin_bit_cast(bf16x8,(u32x4){qxw,0u,0u,0u});
  #define KEXT(w) __builtin_bit_cast(bf16x8,(u32x4){(w),0u,0u,0u})
  #define KEW(tile,half) (*(const __attribute__((address_space(3))) unsigned*)(cke+256*(tile)+128*(half)))
  float l_reg=0.f;f32x16 o[2];o[0]=f32x16{};o[1]=f32x16{};
  const int qrel=wid*QBLK+r32;
  #define CMASK(P0,P1,t) do{int jb_=3-(t); if(jb_>=0)cmask(P0,P1,jb_,qrel,hi);}while(0)
  bool resc=false;
  #define START(P0,P1) do{ const float rm=rowmax(P0,P1); resc=false; \
    { const float dl=(rm>-1e30f)?rm:0.f; cqm=fsub_s(cqm,dl);   \
      _Pragma("unroll") for(int r=0;r<16;++r){P0[r]=fsub_s(P0[r],dl);P1[r]=fsub_s(P1[r],dl);} \
      _Pragma("unroll") for(int r=0;r<16;++r)cq16[r]=cqm; asm volatile("":"+v"(cq16)); } \
    _Pragma("unroll") for(int r=0;r<16;++r)P0[r]=__builtin_amdgcn_exp2f(P0[r]); }while(0)
  #define RESC() do{ if(resc){ asm volatile("s_waitcnt lgkmcnt(0)":::"memory"); \
      _Pragma("unroll") for(int d_=0;d_<2;++d_) _Pragma("unroll") for(int r=0;r<16;++r)o[d_][r]*=wsf[crow(r,hi)]; } }while(0)
  f32x16 pA0,pA1,pB0,pB1;
  int sl_prev=0,sl_cur=0,sl_next=SLOTB;
  #define ROT() do{sl_prev=sl_cur;sl_cur=sl_next;sl_next=(sl_next==(NSLOT-1)*SLOTB)?0:sl_next+SLOTB;}while(0)
  DMA_K(2,2*SLOTB);
  WAIT_BAR(3);
  int NS; { int lo_=0,hi_=NT-4; while(lo_<hi_){ const int mid_=(lo_+hi_)>>1; const float cv_=-unpack_hilo(*(const __attribute__((address_space(3))) unsigned*)(shm3+LDS_CK+4*(64*mid_+63))); if(cv_<=skipthr)hi_=mid_; else lo_=mid_+1; }
    NS=__builtin_amdgcn_readfirstlane((NT-lo_+1)&~1); }
  float cqm=-unpack_hilo(*(const __attribute__((address_space(3))) unsigned*)(shm3+LDS_CK+4*(q0+qrel)));
  f32x16 cq16; _Pragma("unroll") for(int r=0;r<16;++r)cq16[r]=cqm; asm volatile("":"+v"(cq16));
  pA0=cq16; pA1=cq16;
  { const unsigned w0_=KEW(NT-1,0),w1_=KEW(NT-1,1); pA0=__builtin_amdgcn_mfma_f32_32x32x16_bf16(KEXT(w0_),qext,pA0,0,0,0); pA1=__builtin_amdgcn_mfma_f32_32x32x16_bf16(KEXT(w1_),qext,pA1,0,0,0); }
  qkt(pA0,pA1,Kbase,qr,r32,hi);asm volatile("s_nop 15\n\ts_nop 7":"+v"(pA0),"+v"(pA1));CMASK(pA0,pA1,0);
  START(pA0,pA1);
  _Pragma("unroll") for(int r=0;r<16;++r)pA1[r]=__builtin_amdgcn_exp2f(pA1[r]);
  WAIT_BAR(0);
  DMA_K(3,0);DMA_V(1,SLOTB);
  ROT();
  kload8(kf,kp0+sl_cur);
  WAIT_BAR(2);
  s16x4 vlo[8],vhi[8]; u32x4 pw0,pw1,pw2,pw3;
  #define PKW(P,B) cvtpk_s(P[B],P[B+1])
  #define PAF(k) __builtin_bit_cast(bf16x8,pw##k)
  #define VFR(i) (bf16x8){vlo[i][0],vlo[i][1],vlo[i][2],vlo[i][3],vhi[i][0],vhi[i][1],vhi[i][2],vhi[i][3]}
  #define PIN(x) asm volatile("":"+v"(x))
  #define MX3(a,b,c) __builtin_fmaxf(__builtin_fmaxf((a),(b)),(c))
  #define GAPA(MF,A0,A1,A2,A3,W0,W1,PW) do{ MF; sacc+=A0; sacc+=A1; sacc+=A2; sacc+=A3; PIN(sacc); W0; W1; PIN(PW); SBAR(); }while(0)
  #define EX(v) __builtin_amdgcn_exp2f(v)
  #define GAPB(MF,X,B) do{ MF; X[B]=EX(X[B]); X[B+1]=EX(X[B+1]); X[B+2]=EX(X[B+2]); X[B+3]=EX(X[B+3]); PIN(X); SBAR(); }while(0)
  #define VRD(i) do{ vlo[i]=vtr(vp_+(((i)>>2)*4096+((i)&3)*1024)); vhi[i]=vtr(vp_+(((i)>>2)*4096+((i)&3)*1024+512)); }while(0)
  #define KRD(G,j) do{ if(G){ kload2(kf,kp0+sl_next,j); SBAR(); } }while(0)
  #define STEP(C0,C1,P0,P1,t,GK,GV,GL) do{ SBAR(); \
    const unsigned kw0_=KEW(NT-1-(t),0),kw1_=KEW(NT-1-(t),1);   \
    const lds_cptr vp_=vp0+sl_prev; \
    VRD(0); SBAR(); float sacc=(P0[0]+P0[1]); \
    GAPA(C0=__builtin_amdgcn_mfma_f32_32x32x16_bf16(kf[0],qr[0],cq16,0,0,0), P0[2],P0[3],P0[4],P0[5],     pw0[0]=PKW(P0,0), pw0[1]=PKW(P0,2), pw0); \
    VRD(4); SBAR(); GAPA(C1=__builtin_amdgcn_mfma_f32_32x32x16_bf16(kf[1],qr[0],cq16,0,0,0), P0[6],P0[7],P0[8],P0[9],     pw0[2]=PKW(P0,4), pw0[3]=PKW(P0,6), pw0); \
    VRD(1); SBAR(); GAPA(C0=__builtin_amdgcn_mfma_f32_32x32x16_bf16(kf[2],qr[1],C0,0,0,0),   P0[10],P0[11],P0[12],P0[13], pw1[0]=PKW(P0,8), pw1[1]=PKW(P0,10), pw1); \
    VRD(5); SBAR(); GAPA(C1=__builtin_amdgcn_mfma_f32_32x32x16_bf16(kf[3],qr[1],C1,0,0,0),   P0[14],P0[15],P1[0],P1[1],   pw1[2]=PKW(P0,12),pw1[3]=PKW(P0,14), pw1); \
    VRD(2); SBAR(); GAPA(C0=__builtin_amdgcn_mfma_f32_32x32x16_bf16(kf[4],qr[2],C0,0,0,0),   P1[2],P1[3],P1[4],P1[5],     pw2[0]=PKW(P1,0), pw2[1]=PKW(P1,2), pw2); \
    VRD(6); SBAR(); GAPA(C1=__builtin_amdgcn_mfma_f32_32x32x16_bf16(kf[5],qr[2],C1,0,0,0),   P1[6],P1[7],P1[8],P1[9],     pw2[2]=PKW(P1,4), pw2[3]=PKW(P1,6), pw2); \
    VRD(3); SBAR(); GAPA(C0=__builtin_amdgcn_mfma_f32_32x32x16_bf16(kf[6],qr[3],C0,0,0,0),   P1[10],P1[11],P1[12],P1[13], pw3[0]=PKW(P1,8), pw3[1]=PKW(P1,10), pw3); \
    VRD(7); SBAR(); GAPA(C1=__builtin_amdgcn_mfma_f32_32x32x16_bf16(kf[7],qr[3],C1,0,0,0),   P1[14],P1[15],0.f,0.f,       pw3[2]=PKW(P1,12),pw3[3]=PKW(P1,14), pw3); \
    C0=__builtin_amdgcn_mfma_f32_32x32x16_bf16(KEXT(kw0_),qext,C0,0,0,0); C1=__builtin_amdgcn_mfma_f32_32x32x16_bf16(KEXT(kw1_),qext,C1,0,0,0); SBAR(); \
    l_reg+=sacc; \
    if(GK){DMA_K((t)+3,sl_cur);} if(GV){DMA_V((t)+1,sl_next);} \
    CMASK(C0,C1,t); \
    { float a=MX3(C0[0],C0[1],C1[0]),b=MX3(C0[2],C0[3],C1[1]); a=MX3(a,C1[2],C1[3]); \
      _Pragma("unroll") for(int r=4;r<16;r+=4){a=MX3(a,C0[r],C0[r+1]);b=MX3(b,C0[r+2],C0[r+3]);a=MX3(a,C1[r],C1[r+1]);b=MX3(b,C1[r+2],C1[r+3]);} \
      float rm=__builtin_fmaxf(a,b); { auto rr=__builtin_amdgcn_permlane32_swap(__float_as_uint(rm),__float_as_uint(rm),false,false); rm=__builtin_fmaxf(__uint_as_float(rr[0]),__uint_as_float(rr[1])); } \
      resc=false; \
      if(__builtin_expect(__any(rm>(float)THRL),0)){ const float dl=__builtin_fmaxf(rm,0.f); cqm-=dl; \
        _Pragma("unroll") for(int r=0;r<16;++r)cq16[r]=cqm; asm volatile("":"+v"(cq16)); \
        _Pragma("unroll") for(int r=0;r<16;++r){C0[r]-=dl;C1[r]-=dl;} \
        const float f=__builtin_amdgcn_exp2f(-dl); l_reg*=f; if(hi==0)wsf[r32]=f; resc=true; } } \
    SBAR(); \
    GAPB(o[0]=__builtin_amdgcn_mfma_f32_32x32x16_bf16(PAF(0),VFR(0),o[0],0,0,0), C0,0); \
    GAPB(o[1]=__builtin_amdgcn_mfma_f32_32x32x16_bf16(PAF(0),VFR(4),o[1],0,0,0), C0,4); \
    KRD(GL,0); GAPB(o[0]=__builtin_amdgcn_mfma_f32_32x32x16_bf16(PAF(1),VFR(1),o[0],0,0,0), C0,8); \
    KRD(GL,1); GAPB(o[1]=__builtin_amdgcn_mfma_f32_32x32x16_bf16(PAF(1),VFR(5),o[1],0,0,0), C0,12); \
    KRD(GL,2); GAPB(o[0]=__builtin_amdgcn_mfma_f32_32x32x16_bf16(PAF(2),VFR(2),o[0],0,0,0), C1,0); \
    KRD(GL,3); GAPB(o[1]=__builtin_amdgcn_mfma_f32_32x32x16_bf16(PAF(2),VFR(6),o[1],0,0,0), C1,4); \
    GAPB(o[0]=__builtin_amdgcn_mfma_f32_32x32x16_bf16(PAF(3),VFR(3),o[0],0,0,0), C1,8); \
    GAPB(o[1]=__builtin_amdgcn_mfma_f32_32x32x16_bf16(PAF(3),VFR(7),o[1],0,0,0), C1,12); \
    }while(0)
  int t=1;
  for(;t+5<NS;t+=2){
    STEP(pB0,pB1,pA0,pA1,t,true,true,true);     WAIT_BAR(2); RESC(); ROT();
    STEP(pA0,pA1,pB0,pB1,t+1,true,true,true);   WAIT_BAR(2); RESC(); ROT();
  }
  #define ENDW(tt) do{ if((tt)+3<NS){WAIT_BAR(2);} else if((tt)+2<NS){WAIT_BAR(1);} else {WAIT_BAR(0);} }while(0)
  for(;t+1<NS;t+=2){
    STEP(pB0,pB1,pA0,pA1,t,(t+3<NS),(t+1<NS),(t+1<NS));       ENDW(t);   RESC(); ROT();
    STEP(pA0,pA1,pB0,pB1,t+1,(t+4<NS),(t+2<NS),(t+2<NS));     ENDW(t+1); RESC(); ROT();
  }
  STEP(pB0,pB1,pA0,pA1,NS-1,false,false,false); RESC();
  { float sacc=pB0[0]+pB0[1]; _Pragma("unroll") for(int r=2;r<16;++r)sacc+=pB0[r]; _Pragma("unroll") for(int r=0;r<16;++r)sacc+=pB1[r]; l_reg+=sacc;
    pw0=(u32x4){PKW(pB0,0),PKW(pB0,2),PKW(pB0,4),PKW(pB0,6)};pw1=(u32x4){PKW(pB0,8),PKW(pB0,10),PKW(pB0,12),PKW(pB0,14)};pw2=(u32x4){PKW(pB1,0),PKW(pB1,2),PKW(pB1,4),PKW(pB1,6)};pw3=(u32x4){PKW(pB1,8),PKW(pB1,10),PKW(pB1,12),PKW(pB1,14)};
    SBAR(); pv(o,vb0+sl_cur,PAF(0),PAF(1),PAF(2),PAF(3)); }
  #undef PKW
  #undef PAF
  #undef VFR
  #undef PIN
  #undef MX3
  #undef GAPA
  #undef GAPB
  #undef EX
  #undef VRD
  #undef KRD
  #undef STEP
  #undef ENDW
  if(lead_)nxt_=atomicAdd(qctr,1u);
  {auto rr=__builtin_amdgcn_permlane32_swap(__float_as_uint(l_reg),__float_as_uint(l_reg),false,false);l_reg=__uint_as_float(rr[0])+__uint_as_float(rr[1]);}
  if(hi==0)wsf[32+r32]=l_reg;asm volatile("s_waitcnt lgkmcnt(0)":::"memory");
  float rli[16];
  #pragma unroll
  for(int r=0;r<16;++r)rli[r]=__builtin_amdgcn_rcpf(wsf[32+crow(r,hi)]);
  bf16*Ow=O+(rowbase+q0+wid*QBLK)*DM+h*D;
  { bf16*stg=(bf16*)(shm+LDS_OST)+wid*2048;
    #pragma unroll
    for(int r=0;r<16;++r){const int orow=crow(r,hi);
      #pragma unroll
      for(int d0=0;d0<2;++d0)stg[orow*64+d0*32+r32]=__float2bfloat16(o[d0][r]*rli[r]);}
    asm volatile("s_waitcnt lgkmcnt(0)":::"memory");
    #pragma unroll
    for(int i=0;i<4;++i){const int row=i*8+(lane>>3),ch=lane&7; const u32x4 v=*(const u32x4*)(stg+row*64+ch*8); ATTN_STORE16(Ow+(long)row*DM+ch*8,v);} }
  asm volatile("s_waitcnt lgkmcnt(0)\n\ts_barrier":::"memory");
  #undef DMA_K
  #undef DMA_V
  #undef CMASK
  #undef START
  #undef RESC
  #undef ROT
}
constexpr int ATTN_LDS_BYTES=LDS_BYTES;
struct AttnTensors { const bf16* Q; const bf16* K; const bf16* V; bf16* O; const float* CS; const unsigned* nrm; unsigned* qctr; };
template<int THRL=8> __device__ __forceinline__ void attn_phase(char*lds,const AttnTensors&T,volatile __attribute__((address_space(3))) unsigned*qw,int wave_){
  const bool lead_=(wave_==0&&mk_lane_id()==0); unsigned nxt_=0u; if(lead_)nxt_=atomicAdd(T.qctr,1u);
  for(;;){
    if(lead_){ *qw=nxt_; }
    asm volatile("s_waitcnt vmcnt(0) lgkmcnt(0)\n\ts_barrier":::"memory");
    const unsigned u=__builtin_amdgcn_readfirstlane(*qw);
    if(u>=(unsigned)(BATCH*NHEAD*NQB))break;
    const int bh=(int)(u&31u),qb=NQB-1-(int)(u>>5);
    const float qp=__uint_as_float(__hip_atomic_load(T.nrm+bh,__ATOMIC_RELAXED,__HIP_MEMORY_SCOPE_AGENT)),kp=__uint_as_float(__hip_atomic_load(T.nrm+32+bh,__ATOMIC_RELAXED,__HIP_MEMORY_SCOPE_AGENT));
    const float skipthr=160.f+4.1f*sqrtf(qp*kp);
    attn_unit<THRL>(bh/NHEAD,bh%NHEAD,qb,T.Q,T.K,T.V,T.O,T.CS,skipthr,lds,wave_,T.qctr,nxt_,lead_);
  }
}
#undef SBAR
#undef WAIT_BAR
}

#include <hip/hip_cooperative_groups.h>
namespace cg = cooperative_groups;
constexpr int NWAVES = 8;
#ifndef MK_N_LAUNCHES
#define MK_N_LAUNCHES 1
#endif
constexpr int NPH = 11;
constexpr int N_LAUNCHES = MK_N_LAUNCHES;
static_assert(N_LAUNCHES == 1 || N_LAUNCHES == NPH, "MK_N_LAUNCHES is 1 or 11");

constexpr int BATCH = 4, SEQ = 8192, D = 1024, M = BATCH * SEQ, NH = 8;
constexpr int EVEN_IN = 3080, NIN0 = 3072, FFH = 2816, NFF = 2 * FFH, NG = 2048;
constexpr float LN_EPS = 1e-5f, ALPHA = 1.4142135623730951f;

constexpr size_t MiB = 1u << 20;
constexpr size_t WS_CTL = 0, CTL_ZERO_BYTES = 1 * MiB;
constexpr size_t WS_X = 1 * MiB;
constexpr size_t WS_CSUM = 5 * MiB, WS_LOGF = 6 * MiB, WS_RSW = 7 * MiB;
constexpr size_t WS_WIN0 = 8 * MiB, WS_WOUT0 = 14 * MiB, WS_WFI0 = 16 * MiB, WS_WFO0 = 27 * MiB, WS_WIN1 = 33 * MiB, WS_WOUT1 = 37 * MiB, WS_WFI1 = 39 * MiB, WS_WFO1 = 50 * MiB;
constexpr size_t WS_XN = 56 * MiB, WS_MIX = 120 * MiB, WS_BIG = 184 * MiB, WS_PART = 376 * MiB, WS_END = 378 * MiB;
constexpr size_t BUF = (size_t)M * D;
constexpr int CW_NRM = 64, CW_QCTR = 192;
constexpr int CW_TMO = 0, CW_CODE = 1, CW_SEAM = 16384, SEAM_BANK = 128 * 64;
static_assert((CW_SEAM + 4 * SEAM_BANK) * 4 <= (int)CTL_ZERO_BYTES, "CTL words inside the memset region");

constexpr int RING_BYTES = 131072, LDS_BYTES = 147456, MISC_OFF = LDS_BYTES - 256;
static_assert(attn_body::ATTN_LDS_BYTES <= RING_BYTES, "attention scratch fits the ring region");

#define LAS __attribute__((address_space(3)))
typedef unsigned short bf16;
typedef unsigned v4u __attribute__((ext_vector_type(4)));
typedef unsigned v2u __attribute__((ext_vector_type(2)));
typedef float f32x4 __attribute__((ext_vector_type(4)));
typedef short bf16x8 __attribute__((ext_vector_type(8)));
typedef float f32x16 __attribute__((ext_vector_type(16)));
#define RLX_AGENT __ATOMIC_RELAXED, __HIP_MEMORY_SCOPE_AGENT
#define LDS_WAIT() asm volatile("s_waitcnt lgkmcnt(0)" ::: "memory")
__device__ __forceinline__ unsigned f2bf(float f) { unsigned u = __builtin_bit_cast(unsigned, f); return (u + 0x7fffu + ((u >> 16) & 1u)) >> 16; }
__device__ __forceinline__ unsigned pk2(float lo, float hi) { return f2bf(lo) | (f2bf(hi) << 16); }
__device__ __forceinline__ float bf2f(unsigned short h) { return __builtin_bit_cast(float, (unsigned)h << 16); }
__device__ __forceinline__ float bflo(unsigned w) { return __builtin_bit_cast(float, w << 16); }
__device__ __forceinline__ float bfhi(unsigned w) { return __builtin_bit_cast(float, w & 0xffff0000u); }

#define XB_TMO      128
#define XB_XCNT(j)  (256  + 64 * (j))
#define XB_XSUB(j)  (1280 + 64 * (j))
#define XB_XGEN(j)  (2304 + 64 * (j))
#define XB_TOP      3328
#define XB_TOPGEN   3392
#define XCD_BAR_WORDS 3456
#define XB_SPIN_CAP (1u << 18)

__device__ __forceinline__ unsigned xb_ld(unsigned* p)              { return __hip_atomic_load(p, __ATOMIC_RELAXED, __HIP_MEMORY_SCOPE_AGENT); }
__device__ __forceinline__ unsigned xb_add(unsigned* p, unsigned v) { return __hip_atomic_fetch_add(p, v, __ATOMIC_RELAXED, __HIP_MEMORY_SCOPE_AGENT); }
__device__ __forceinline__ unsigned xb_xcc_id() { return (unsigned)__builtin_amdgcn_s_getreg((3 << 11) | 20) & 0xFu; }
#define XB_SPIN(cond, bar) do { unsigned _sp = 0; while (cond) { __builtin_amdgcn_s_sleep(1); \
    if ((++_sp & 255u) == 0u) { if (xb_ld(&(bar)[XB_TMO])) break; if (_sp > XB_SPIN_CAP) { atomicAdd(&(bar)[XB_TMO], 1u); break; } } } } while (0)

struct XcdBarrier {
    unsigned* bar; unsigned x;
    volatile LAS unsigned* st;
};

__device__ __forceinline__ XcdBarrier xcd_barrier_post(unsigned* bar, volatile LAS unsigned* st) {
    XcdBarrier b; b.bar = bar; b.x = xb_xcc_id(); b.st = st;
    if (threadIdx.x == 0) (void)xb_add(&bar[XB_XCNT(b.x)], 1u);
    return b;
}
__device__ __forceinline__ void xcd_barrier_complete(unsigned* bar, unsigned x, unsigned& nloc, unsigned& nx) {
    const unsigned G = gridDim.x * gridDim.y * gridDim.z;
    unsigned sum, cnt, mine, sp = 0u;
    for (;;) {
        sum = 0u; cnt = 0u; mine = 0u;
#pragma unroll
        for (unsigned j = 0; j < 16; ++j) { const unsigned c = xb_ld(&bar[XB_XCNT(j)]); sum += c; cnt += (c > 0u) ? 1u : 0u; mine = (j == x) ? c : mine; }
        if (sum == G) break;
        __builtin_amdgcn_s_sleep(1);
        if ((++sp & 255u) == 0u) { if (xb_ld(&bar[XB_TMO])) break; if (sp > XB_SPIN_CAP) { atomicAdd(&bar[XB_TMO], 1u); break; } }
    }
    nloc = mine > 0u ? mine : 1u; nx = cnt > 0u ? cnt : 1u;
}

__device__ __forceinline__ void xcd_barrier(const XcdBarrier& b) {
    asm volatile("s_waitcnt vmcnt(0)" ::: "memory");
    __syncthreads();
    if (threadIdx.x == 0) {
        unsigned* bar = b.bar;
        __builtin_amdgcn_s_waitcnt(0);
        unsigned nloc = b.st[0], nx = b.st[1];
        if (nloc == 0u) { xcd_barrier_complete(bar, b.x, nloc, nx); b.st[0] = nloc; b.st[1] = nx; }
        const unsigned old = xb_add(&bar[XB_XSUB(b.x)], 1u);
        const unsigned gen = old / nloc;
        if (old + 1u == (gen + 1u) * nloc) {
            __builtin_amdgcn_fence(__ATOMIC_RELEASE, "agent");
            asm volatile("s_waitcnt vmcnt(0)" ::: "memory");
            const unsigned og = xb_add(&bar[XB_TOP], 1u);
            const unsigned tg = og / nx;
            if (og + 1u == (tg + 1u) * nx) xb_add(&bar[XB_TOPGEN], 1u);
            else XB_SPIN(xb_ld(&bar[XB_TOPGEN]) == tg, bar);
            __builtin_amdgcn_fence(__ATOMIC_ACQUIRE, "agent");
            xb_add(&bar[XB_XGEN(b.x)], 1u);
            asm volatile("s_waitcnt vmcnt(0)" ::: "memory");
        } else {
            XB_SPIN(xb_ld(&bar[XB_XGEN(b.x)]) == gen, bar);
            __builtin_amdgcn_fence(__ATOMIC_ACQUIRE, "agent");
            asm volatile("s_waitcnt vmcnt(0)" ::: "memory");
        }
    }
    __syncthreads();
}
constexpr int CW_BAR = 4096;
static_assert(CW_BAR + XCD_BAR_WORDS <= 16384, "barrier words below the panel counters");

struct Frame {
    LAS unsigned char* lds; unsigned char* ldsg;
    unsigned* ctl; unsigned char* ws;
    int wave, vcu, G;
};
struct Args { const float* in[17]; float* out; unsigned char* ws; int ph_lo, ph_hi; };
typedef const __attribute__((address_space(4))) Args* kargs_ptr;
__device__ __forceinline__ kargs_ptr kargs() {
#if defined(__HIP_DEVICE_COMPILE__)
    unsigned long long p = (unsigned long long)__builtin_amdgcn_kernarg_segment_ptr(); asm volatile("" : "+s"(p)); return (kargs_ptr)p;
#else
    return nullptr;
#endif
}

__device__ __forceinline__ float wave_sum(float v) {
#pragma unroll
    for (int o = 1; o < 64; o <<= 1) v += __shfl_xor(v, o);
    return v;
}
__device__ __forceinline__ void tr_item(const float* W, int K, int ldw, int srccol0, bf16* WT, int dstrow0, int k0, float scale, LAS float* scr, int lane) {
#pragma unroll 8
    for (int i = 0; i < 32; ++i) { const int kk = 2 * i + (lane >> 5); scr[kk * 33 + (lane & 31)] = __builtin_nontemporal_load(W + (size_t)(k0 + kk) * ldw + srccol0 + (lane & 31)) * scale; }
    LDS_WAIT(); asm volatile("" ::: "memory");
    const int c = lane & 7;
#pragma unroll
    for (int j = 0; j < 4; ++j) { const int n = (lane >> 3) + 8 * j; const LAS float* sp = scr + (8 * c) * 33 + n;
        v4u o; o.x = pk2(sp[0 * 33], sp[1 * 33]); o.y = pk2(sp[2 * 33], sp[3 * 33]); o.z = pk2(sp[4 * 33], sp[5 * 33]); o.w = pk2(sp[6 * 33], sp[7 * 33]);
        *(v4u*)(WT + (size_t)(dstrow0 + n) * K + k0 + 8 * c) = o; }
    LDS_WAIT(); asm volatile("" ::: "memory");
}

__device__ __forceinline__ void p0_prologue(Frame& F) {
    LAS float* scr = (LAS float*)(F.lds + F.wave * 16384);
    kargs_ptr KA = kargs(); const int gw = F.vcu * NWAVES + F.wave, NGW = F.G * NWAVES, lane = mk_lane_id();
    constexpr int I_IN0 = 16 * 96, I_OUT = 16 * 32, I_FI = 16 * 176, I_FO = 44 * 32, I_IN1 = 16 * 64;
    constexpr int NITEMS = I_IN0 + 2 * I_OUT + 2 * I_FI + 2 * I_FO + I_IN1;
    unsigned char* ws = F.ws;
    for (int it = gw; it < NITEMS; it += NGW) {
        int r = it;
        if (r < I_IN0) { const int kb = r / 96, n0 = 32 * (r % 96); tr_item(KA->in[1], D, EVEN_IN, n0 < 1536 ? n0 : n0 + 8, (bf16*)(ws + WS_WIN0), n0, 64 * kb, n0 < 512 ? attn_body::C2 : 1.0f, scr, lane); continue; } r -= I_IN0;
        if (r < I_OUT) { const int kb = r / 32, n0 = 32 * (r % 32); tr_item(KA->in[4], D, D, n0, (bf16*)(ws + WS_WOUT0), n0, 64 * kb, 1.0f, scr, lane); continue; } r -= I_OUT;
        if (r < I_OUT) { const int kb = r / 32, n0 = 32 * (r % 32); tr_item(KA->in[10], D, D, n0, (bf16*)(ws + WS_WOUT1), n0, 64 * kb, 1.0f, scr, lane); continue; } r -= I_OUT;
        if (r < 2 * I_FI) { const int l = r / I_FI; r -= l * I_FI; const int kb = r / 176, n0 = 32 * (r % 176); const int src = FFH * ((n0 >> 7) & 1) + 128 * (n0 >> 8) + (n0 & 127);
            tr_item(KA->in[13] + (size_t)l * D * NFF, D, NFF, src, (bf16*)(ws + (l ? WS_WFI1 : WS_WFI0)), n0, 64 * kb, 1.0f, scr, lane); continue; } r -= 2 * I_FI;
        if (r < 2 * I_FO) { const int l = r / I_FO; r -= l * I_FO; const int kb = r / 32, n0 = 32 * (r % 32);
            tr_item(KA->in[14] + (size_t)l * FFH * D, FFH, D, n0, (bf16*)(ws + (l ? WS_WFO1 : WS_WFO0)), n0, 64 * kb, 1.0f, scr, lane); continue; } r -= 2 * I_FO;
        { const int kb = r / 64, n0 = 32 * (r % 64); tr_item(KA->in[5], D, NG, n0, (bf16*)(ws + WS_WIN1), n0, 64 * kb, 1.0f, scr, lane); }
    }
    { v4u* xz = (v4u*)(ws + WS_X); const v4u z4 = (v4u){0u, 0u, 0u, 0u}; for (int i = gw * 64 + lane; i < (int)(4 * MiB / 16); i += NGW * 64) xz[i] = z4; }
    if (gw < 1024) { const float* wr = KA->in[8] + (size_t)gw * 128; const int i = gw & 127; float v = wr[lane] + (i >= 64 ? wr[64 + lane] : 0.f); v = wave_sum(v); if (lane == 0) ((float*)(ws + WS_RSW))[gw] = v; }
    float wf[16][8];
#pragma unroll
    for (int j = 0; j < 4; ++j)
#pragma unroll
        for (int e = 0; e < 4; ++e) { const float* p = KA->in[1] + (size_t)(4 * lane + 256 * j + e) * EVEN_IN + 1536; const f32x4 a = *(const f32x4*)p, b = *(const f32x4*)(p + 4);
            wf[j * 4 + e][0] = a[0]; wf[j * 4 + e][1] = a[1]; wf[j * 4 + e][2] = a[2]; wf[j * 4 + e][3] = a[3]; wf[j * 4 + e][4] = b[0]; wf[j * 4 + e][5] = b[1]; wf[j * 4 + e][6] = b[2]; wf[j * 4 + e][7] = b[3]; }
    const float bfl = KA->in[2][lane & 7];
    bf16* XN = (bf16*)(ws + WS_XN); float* LOGF = (float*)(ws + WS_LOGF);
    for (int m = gw; m < M; m += NGW) {
        const f32x4* xr = (const f32x4*)(KA->in[0] + (size_t)m * D) + lane;
        f32x4 v[4];
#pragma unroll
        for (int j = 0; j < 4; ++j) v[j] = __builtin_nontemporal_load(xr + 64 * j);
        float a[8];
#pragma unroll
        for (int h = 0; h < 8; ++h) a[h] = 0.f;
#pragma unroll
        for (int j = 0; j < 4; ++j)
#pragma unroll
            for (int e = 0; e < 4; ++e)
#pragma unroll
                for (int h = 0; h < 8; ++h) a[h] += v[j][e] * wf[j * 4 + e][h];
#pragma unroll
        for (int h = 0; h < 8; ++h) a[h] = wave_sum(a[h]);
        unsigned long long* o8 = (unsigned long long*)(XN + (size_t)m * D) + lane;
#pragma unroll
        for (int j = 0; j < 4; ++j) o8[64 * j] = (unsigned long long)pk2(v[j][0], v[j][1]) | ((unsigned long long)pk2(v[j][2], v[j][3]) << 32);
        if (lane < 8) { float z = a[0];
#pragma unroll
            for (int h = 1; h < 8; ++h) z = (lane == h) ? a[h] : z;
            z += bfl;
            const float lf = (z >= 0.f) ? -log1pf(expf(-z)) : z - log1pf(expf(z));
            LOGF[(size_t)((m >> 13) * NH + lane) * SEQ + (m & (SEQ - 1))] = lf; }
    }
}

__device__ __forceinline__ void p1_scan(Frame& F, int bh) {
    const float* lf = (const float*)(F.ws + WS_LOGF) + (size_t)bh * SEQ; float* c = (float*)(F.ws + WS_CSUM) + (size_t)bh * SEQ;
    LAS float* wt = (LAS float*)(F.lds + MISC_OFF + 64); const int lane = mk_lane_id(), tid = F.wave * 64 + lane;
    f32x4 v[4]; float run = 0.f;
#pragma unroll
    for (int j = 0; j < 4; ++j) { v[j] = *(const f32x4*)(lf + 16 * tid + 4 * j);
#pragma unroll
        for (int e = 0; e < 4; ++e) { run += v[j][e]; v[j][e] = run; } }
    float inc = run;
#pragma unroll
    for (int o = 1; o < 64; o <<= 1) { const float t = __shfl_up(inc, o); if (lane >= o) inc += t; }
    if (lane == 63) wt[F.wave] = inc;
    __syncthreads();
    float off = inc - run;
    for (int w = 0; w < F.wave; ++w) off += wt[w];
#pragma unroll
    for (int j = 0; j < 4; ++j) *(f32x4*)(c + 16 * tid + 4 * j) = v[j] + off;
    __syncthreads();
}

__device__ __forceinline__ void p2_conv(Frame& F) {
    const bf16* VB = (const bf16*)(F.ws + WS_BIG) + BUF; const bf16* CH = (const bf16*)(F.ws + WS_BIG) + 2 * BUF; bf16* MIX = (bf16*)(F.ws + WS_MIX);
    const int lane = mk_lane_id(); const float* cw = kargs()->in[3];
    float w0[8], w1[8], w2[8];
#pragma unroll
    for (int e = 0; e < 8; ++e) { w0[e] = cw[8 * lane + e]; w1[e] = cw[512 + 8 * lane + e]; w2[e] = cw[1024 + 8 * lane + e]; }
    for (int rb = F.vcu * NWAVES + F.wave; rb < M / 16; rb += F.G * NWAVES) {
        const int t0 = rb * 16; float z1[8], z2[8];
#pragma unroll
        for (int e = 0; e < 8; ++e) { z1[e] = 0.f; z2[e] = 0.f; }
        if ((t0 & (SEQ - 1)) != 0) {
            const v4u c1 = *(const v4u*)(CH + (size_t)(t0 - 1) * D + 8 * lane), h1 = *(const v4u*)(CH + (size_t)(t0 - 1) * D + 512 + 8 * lane);
            const v4u c2 = *(const v4u*)(CH + (size_t)(t0 - 2) * D + 8 * lane), h2 = *(const v4u*)(CH + (size_t)(t0 - 2) * D + 512 + 8 * lane);
#pragma unroll
            for (int e = 0; e < 4; ++e) { z1[2 * e] = bflo(c1[e]) * bflo(h1[e]); z1[2 * e + 1] = bfhi(c1[e]) * bfhi(h1[e]); z2[2 * e] = bflo(c2[e]) * bflo(h2[e]); z2[2 * e + 1] = bfhi(c2[e]) * bfhi(h2[e]); }
        }
#pragma unroll 8
        for (int r = 0; r < 16; ++r) { const size_t t = (size_t)(t0 + r);
            const v4u cg_ = __builtin_nontemporal_load((const v4u*)(CH + t * D + 8 * lane)), hc = __builtin_nontemporal_load((const v4u*)(CH + t * D + 512 + 8 * lane)), bg = __builtin_nontemporal_load((const v4u*)(VB + t * D + 512 + 8 * lane));
            float z[8], y[8];
#pragma unroll
            for (int e = 0; e < 4; ++e) { z[2 * e] = bflo(cg_[e]) * bflo(hc[e]); z[2 * e + 1] = bfhi(cg_[e]) * bfhi(hc[e]); }
#pragma unroll
            for (int e = 0; e < 8; ++e) y[e] = w0[e] * z2[e] + w1[e] * z1[e] + w2[e] * z[e];
            v4u o;
#pragma unroll
            for (int e = 0; e < 4; ++e) o[e] = pk2(bflo(bg[e]) * y[2 * e], bfhi(bg[e]) * y[2 * e + 1]);
            *(v4u*)(MIX + t * D + 512 + 8 * lane) = o;
#pragma unroll
            for (int e = 0; e < 8; ++e) { z2[e] = z1[e]; z1[e] = z[e]; } }
    }
}

__device__ __forceinline__ void p7_spatial(Frame& F) {
    const bf16* U = (const bf16*)(F.ws + WS_BIG); const bf16* VT = (const bf16*)(F.ws + WS_BIG) + BUF; bf16* GT = (bf16*)(F.ws + WS_MIX);
    kargs_ptr KA = kargs(); const float* lng = KA->in[6]; const float* lnb = KA->in[7]; const float* wsp = KA->in[8]; const float* bsp = KA->in[9]; const float* rsw = (const float*)(F.ws + WS_RSW);
    LAS unsigned char* Wt = F.lds; LAS unsigned char* Vt = F.lds + 34816;
    LAS float* stat = (LAS float*)(F.lds + 69632);
    LAS float* c1s = (LAS float*)(F.lds + 70656);
    LAS float* stage = (LAS float*)(F.lds + 71680);
    LAS float* red = stage;
    const int lane = mk_lane_id(), wave = F.wave, tid = wave * 64 + lane, li = lane & 31, kh = lane >> 5;
    for (int tb = F.vcu; tb < M / 128; tb += F.G) {
        const size_t tok0 = (size_t)tb * 128;
        if (tid < 128) { const f32x4* pp = (const f32x4*)((const float*)(F.ws + WS_PART) + (tok0 + tid) * 16); float s = 0.f, q = 0.f;
#pragma unroll
            for (int k = 0; k < 4; ++k) { const f32x4 v = pp[k]; s += v[0]; q += v[1]; s += v[2]; q += v[3]; }
            const float mean = s * (1.f / 1024.f), var = fmaxf(q * (1.f / 1024.f) - mean * mean, 0.f);
            stat[tid] = mean; stat[128 + tid] = 1.0f / sqrtf(var + LN_EPS); }
        __syncthreads();
        const int dt = wave & 3, ih = wave >> 2, i0 = 64 * ih, nks = ih ? 8 : 4;
        const int srow = tid >> 2, seg = tid & 3;
        const bool wact = (srow >= 64) || (seg < 2);
        v4u vv[4]; f32x4 wv[8];
#define P7_LOAD(gg) do { const v4u* vsrc_ = (const v4u*)(VT + (size_t)(128 * (gg) + srow) * M + tok0 + 32 * seg); _Pragma("unroll") for (int e = 0; e < 4; ++e) vv[e] = __builtin_nontemporal_load(vsrc_ + e); \
            if (wact) { const f32x4* wsrc_ = (const f32x4*)(wsp + (size_t)((gg) * 128 + srow) * 128 + 32 * seg); _Pragma("unroll") for (int e = 0; e < 8; ++e) wv[e] = wsrc_[e]; } } while (0)
        P7_LOAD(0);
        for (int g = 0; g < 8; ++g) {
            v4u uu4[4];
#pragma unroll
            for (int ps = 0; ps < 4; ++ps) uu4[ps] = __builtin_nontemporal_load((const v4u*)(U + (tok0 + 32 * ps + (tid >> 4)) * D + 128 * g + 8 * (tid & 15)));
            const int chf = 128 * g + 8 * (tid & 15);
            const f32x4 gl0 = *(const f32x4*)(lng + chf), gl1 = *(const f32x4*)(lng + chf + 4), bl0 = *(const f32x4*)(lnb + chf), bl1 = *(const f32x4*)(lnb + chf + 4);
            float rsv[4], bsvv[4];
#pragma unroll
            for (int ps = 0; ps < 4; ++ps) { rsv[ps] = rsw[g * 128 + 32 * ps + (tid >> 4)]; bsvv[ps] = bsp[g * 128 + 32 * ps + (tid >> 4)]; }
            { const int row = srow;
              float c1p = 0.f;
              if (wact) {
#pragma unroll
                  for (int e = 0; e < 8; ++e) { const f32x4 rr = *(const LAS f32x4*)(stat + 128 + 32 * seg + 4 * e), mm = *(const LAS f32x4*)(stat + 32 * seg + 4 * e); wv[e] = wv[e] * rr;
                      c1p += (wv[e][0] * mm[0] + wv[e][1] * mm[1]) + (wv[e][2] * mm[2] + wv[e][3] * mm[3]); }
#pragma unroll
                  for (int e = 0; e < 4; ++e) { v4u wq; wq.x = pk2(wv[2 * e][0], wv[2 * e][1]); wq.y = pk2(wv[2 * e][2], wv[2 * e][3]); wq.z = pk2(wv[2 * e + 1][0], wv[2 * e + 1][1]); wq.w = pk2(wv[2 * e + 1][2], wv[2 * e + 1][3]);
                      *(LAS v4u*)(Wt + row * 272 + 64 * seg + 16 * e) = wq; } }
              c1p += __shfl_xor(c1p, 1); c1p += __shfl_xor(c1p, 2);
              if (seg == 0) c1s[row] = c1p;
#pragma unroll
              for (int e = 0; e < 4; ++e) *(LAS v4u*)(Vt + row * 272 + 64 * seg + 16 * e) = vv[e]; }
            asm volatile("s_waitcnt lgkmcnt(0)\n\ts_barrier" ::: "memory");
            if (g < 7) P7_LOAD(g + 1);
            f32x16 acc[2]; acc[0] = f32x16{}; acc[1] = f32x16{}; float c1[2];
            c1[0] = c1s[i0 + li]; c1[1] = c1s[i0 + 32 + li];
#pragma unroll
            for (int ks = 0; ks < 8; ++ks) if (ks < nks) {
                const bf16x8 vf = *(const LAS bf16x8*)(Vt + (32 * dt + li) * 272 + (16 * ks + 8 * kh) * 2);
#pragma unroll
                for (int it = 0; it < 2; ++it) { const bf16x8 wf = *(const LAS bf16x8*)(Wt + (i0 + 32 * it + li) * 272 + (16 * ks + 8 * kh) * 2);
                    acc[it] = __builtin_amdgcn_mfma_f32_32x32x16_bf16(vf, wf, acc[it], 0, 0, 0); }
            }
#pragma unroll
            for (int it = 0; it < 2; ++it) {
                LAS float* sp = stage + (i0 + 32 * it + li) * 132 + 32 * dt + 4 * kh;
#pragma unroll
                for (int rg = 0; rg < 4; ++rg) { f32x4 o; o[0] = acc[it][4 * rg + 0] - c1[it]; o[1] = acc[it][4 * rg + 1] - c1[it]; o[2] = acc[it][4 * rg + 2] - c1[it]; o[3] = acc[it][4 * rg + 3] - c1[it]; *(LAS f32x4*)(sp + 8 * rg) = o; } }
            asm volatile("s_waitcnt lgkmcnt(0)\n\ts_barrier" ::: "memory");
            { const int chk = tid & 15, ch = 128 * g + 8 * chk;
#pragma unroll
              for (int ps = 0; ps < 4; ++ps) { const int row = 32 * ps + (tid >> 4); const size_t tok = tok0 + row; const float rs = rsv[ps], bsv = bsvv[ps];
                  const v4u uu = uu4[ps];
                  const f32x4 a0 = *(const LAS f32x4*)(stage + row * 132 + 8 * chk), a1 = *(const LAS f32x4*)(stage + row * 132 + 8 * chk + 4);
                  const f32x4 s0 = gl0 * a0 + (bl0 * rs + bsv), s1 = gl1 * a1 + (bl1 * rs + bsv);
                  v4u o; o.x = pk2(bflo(uu.x) * s0[0], bfhi(uu.x) * s0[1]); o.y = pk2(bflo(uu.y) * s0[2], bfhi(uu.y) * s0[3]); o.z = pk2(bflo(uu.z) * s1[0], bfhi(uu.z) * s1[1]); o.w = pk2(bflo(uu.w) * s1[2], bfhi(uu.w) * s1[3]);
                  *(v4u*)(GT + tok * D + ch) = o; } }
            asm volatile("s_waitcnt lgkmcnt(0)\n\ts_barrier" ::: "memory");
        }
        __syncthreads();
    }
}

__device__ __forceinline__ void ln_gemm(Frame& F, const bf16* A, const bf16* Wt, int K, const float* base, const bf16* basebf, float* out, bf16* xn, const float* gam, const float* bet, int bank) {
    const unsigned poison = (__hip_atomic_load(F.ctl + CW_TMO, RLX_AGENT) != 0u);
    if (F.G != 256) return;
#pragma unroll 1
    for (int sub = 0; sub < 2; ++sub) {
        const size_t r0 = (size_t)sub * 16384;
        pg8::Gemm g{A + r0 * K, Wt, 16384, D, K}; pg8::StaticOrder S; S.init(16384, D, F.G, (int)blockIdx.x);
        pg8::PanelStats st{(unsigned*)(F.ws + WS_X + (size_t)bank * MiB + (size_t)sub * 524288), F.ctl + CW_SEAM + bank * SEAM_BANK + sub * 4096, F.ctl + CW_TMO, D / 256, LN_EPS, 0x700u + 16u * bank + sub};
        pg8::EpiLnAff E{base ? base + r0 * D : nullptr, basebf ? basebf + r0 * D : nullptr, out ? out + r0 * D : nullptr, xn ? xn + r0 * D : nullptr, D, gam, bet, ALPHA, st, poison};
        pg8::gemm_phase<pg8::EpiLnAff, pg8::StaticOrder, false, PG8_SP2>(F.lds, g, S, E, F.wave);
        __syncthreads();
    }
}

__global__ void __launch_bounds__(NWAVES * 64, 2) trunk_fwd(Args args) {
    extern __shared__ __attribute__((aligned(16))) unsigned char lds[];
    Frame F;
    F.lds = (LAS unsigned char*)lds; F.ldsg = lds;
    F.wave = __builtin_amdgcn_readfirstlane((int)threadIdx.x >> 6);
    F.G = gridDim.x; { const int bx = blockIdx.x; F.vcu = (F.G % 8 == 0) ? (bx % 8) * (F.G / 8) + bx / 8 : bx; }
    F.ws = args.ws; F.ctl = (unsigned*)(args.ws + WS_CTL);
    unsigned char* ws = args.ws;
    bf16* XN = (bf16*)(ws + WS_XN); bf16* MIX = (bf16*)(ws + WS_MIX); bf16* BIG = (bf16*)(ws + WS_BIG);
    const int lo = args.ph_lo, hi = args.ph_hi;
    { volatile LAS unsigned* misc = (volatile LAS unsigned*)(F.lds + MISC_OFF); if (threadIdx.x < 32) misc[threadIdx.x] = 0u; }
    __syncthreads();
    XcdBarrier bar; bar.bar = F.ctl + CW_BAR; bar.x = 0; bar.st = nullptr;
    if (N_LAUNCHES == 1) bar = xcd_barrier_post(F.ctl + CW_BAR, (volatile LAS unsigned*)(F.lds + MISC_OFF) + 8);
#ifndef PHMASK
#define PHMASK 0x7ffu
#endif
#define IN(k) (((PHMASK >> (k)) & 1u) && lo <= (k) && (k) < hi)
#define SEAM(k) do { if (IN(k) && IN((k) + 1)) { if (hi > NPH) cg::this_grid().sync(); else xcd_barrier(bar); } } while (0)

    if (IN(0)) { p0_prologue(F); __syncthreads(); }
    SEAM(0);
    if (IN(1)) {
        if (F.vcu < BATCH * NH) p1_scan(F, F.vcu);
        pg8::Gemm g{XN, (const bf16*)(ws + WS_WIN0), M, NIN0, D}; pg8::StaticOrder S; S.init(M, NIN0, F.G, (int)blockIdx.x);
        pg8::EpiBf16QK E{BIG, D, D, BUF, F.ctl + CW_NRM};
        pg8::gemm_phase<pg8::EpiBf16QK, pg8::StaticOrder, PG8_ALIGN, PG8_SP2>(F.lds, g, S, E, F.wave);
    }
    SEAM(1);
    if (IN(2)) {
        const attn_body::AttnTensors AT{(const attn_body::bf16*)BIG, (const attn_body::bf16*)(BIG + 512), (const attn_body::bf16*)(BIG + BUF), (attn_body::bf16*)MIX, (const float*)(ws + WS_CSUM), F.ctl + CW_NRM, F.ctl + CW_QCTR};
        attn_body::attn_phase<8>((char*)lds, AT, (volatile LAS unsigned*)(F.lds + MISC_OFF) + 16, F.wave);
        p2_conv(F);
    }
    SEAM(2);
    if (IN(3)) { kargs_ptr KA = kargs(); ln_gemm(F, MIX, (const bf16*)(ws + WS_WOUT0), D, nullptr, XN, nullptr, XN, KA->in[11], KA->in[12], 0); }
    SEAM(3);
    if (IN(4)) {
        pg8::Gemm g{XN, (const bf16*)(ws + WS_WFI0), M, NFF, D}; pg8::StaticOrder S; S.init(M, NFF, F.G, (int)blockIdx.x);
        pg8::EpiSwiGLU E{BIG, FFH};
        pg8::gemm_phase<pg8::EpiSwiGLU, pg8::StaticOrder, PG8_ALIGN, PG8_SP2>(F.lds, g, S, E, F.wave);
    }
    SEAM(4);
    if (IN(5)) { kargs_ptr KA = kargs(); ln_gemm(F, BIG, (const bf16*)(ws + WS_WFO0), FFH, nullptr, XN, nullptr, XN, KA->in[15], KA->in[16], 1); }
    SEAM(5);
    if (IN(6)) {
        { pg8::Gemm g{XN, (const bf16*)(ws + WS_WIN1), M, D, D}; pg8::StaticOrder S; S.init(M, D, F.G, (int)blockIdx.x);
          pg8::EpiBf16<1> E{BIG, D, nullptr, 0, 0, 1.0f};
          pg8::gemm_phase<pg8::EpiBf16<1>, pg8::StaticOrder, PG8_ALIGN, PG8_SP2>(F.lds, g, S, E, F.wave); }
        __syncthreads();
        { pg8::Gemm g{(const bf16*)(ws + WS_WIN1) + (size_t)D * D, XN, D, M, D}; pg8::StaticOrder S; S.init(D, M, F.G, (int)blockIdx.x);
          pg8::EpiBf16VT E{BIG + BUF, M, (float*)(ws + WS_PART)};
          pg8::gemm_phase<pg8::EpiBf16VT, pg8::StaticOrder, PG8_ALIGN, PG8_SP2>(F.lds, g, S, E, F.wave); }
    }
    SEAM(6);
    if (IN(7)) p7_spatial(F);
    SEAM(7);
    if (IN(8)) { kargs_ptr KA = kargs(); ln_gemm(F, MIX, (const bf16*)(ws + WS_WOUT1), D, nullptr, XN, nullptr, XN, KA->in[11] + D, KA->in[12] + D, 2); }
    SEAM(8);
    if (IN(9)) {
        pg8::Gemm g{XN, (const bf16*)(ws + WS_WFI1), M, NFF, D}; pg8::StaticOrder S; S.init(M, NFF, F.G, (int)blockIdx.x);
        pg8::EpiSwiGLU E{BIG, FFH};
        pg8::gemm_phase<pg8::EpiSwiGLU, pg8::StaticOrder, PG8_ALIGN, PG8_SP2>(F.lds, g, S, E, F.wave);
    }
    SEAM(9);
    if (IN(10)) { kargs_ptr KA = kargs(); ln_gemm(F, BIG, (const bf16*)(ws + WS_WFO1), FFH, nullptr, XN, KA->out, nullptr, KA->in[15] + D, KA->in[16] + D, 3); }
#undef IN
#undef SEAM
}

extern "C" void kernel_launch(void* const* d_in, const int* in_sizes, int n_in, void* d_out, int out_size, void* d_ws, size_t ws_size, hipStream_t stream) {
    static int grid = 0;
    if (grid == 0) {
        if (n_in != 17 || in_sizes[0] != M * D || out_size != M * D || ws_size < WS_END) { fprintf(stderr, "kernel_launch: unexpected shapes (n_in %d, in0 %d, out %d, ws %zu)\n", n_in, n_in > 0 ? in_sizes[0] : -1, out_size, ws_size); grid = -1; return; }
        int dev = 0, cus = 0, per_cu = 0;
        if (hipGetDevice(&dev) != hipSuccess || hipDeviceGetAttribute(&cus, hipDeviceAttributeMultiprocessorCount, dev) != hipSuccess) { grid = -1; return; }
        if (hipFuncSetAttribute((const void*)trunk_fwd, hipFuncAttributeMaxDynamicSharedMemorySize, LDS_BYTES) != hipSuccess) { fprintf(stderr, "kernel_launch: hipFuncSetAttribute failed\n"); grid = -1; return; }
        if (hipOccupancyMaxActiveBlocksPerMultiprocessor(&per_cu, (const void*)trunk_fwd, NWAVES * 64, LDS_BYTES) != hipSuccess || per_cu < 1) fprintf(stderr, "kernel_launch: occupancy query reports %d workgroups per CU\n", per_cu);
        (void)hipGetLastError();
        grid = cus;
    }
    if (grid < 0) return;
    if (hipMemsetAsync((char*)d_ws + WS_CTL, 0, CTL_ZERO_BYTES, stream) != hipSuccess) { fprintf(stderr, "kernel_launch: hipMemsetAsync failed\n"); return; }
    Args a{};
    for (int i = 0; i < 17; ++i) a.in[i] = (const float*)d_in[i];
    a.out = (float*)d_out; a.ws = (unsigned char*)d_ws;
    if (N_LAUNCHES == 1) {
        a.ph_lo = 0; a.ph_hi = NPH;
        void* kargs[] = {&a};
        const hipError_t e = hipLaunchCooperativeKernel((const void*)trunk_fwd, dim3(grid), dim3(NWAVES * 64), kargs, LDS_BYTES, stream);
        if (e != hipSuccess) fprintf(stderr, "kernel_launch: cooperative launch failed: %s (grid %d)\n", hipGetErrorString(e), grid);
    } else {
        for (int li = 0; li < NPH; ++li) { a.ph_lo = li; a.ph_hi = li + 1;
            hipLaunchKernelGGL(trunk_fwd, dim3(grid), dim3(NWAVES * 64), LDS_BYTES, stream, a);
            const hipError_t le = hipPeekAtLastError();
            if (le != hipSuccess) { fprintf(stderr, "kernel_launch: launch %d failed: %s\n", li, hipGetErrorName(le)); break; } }
    }
}
```
